# Optimizing an MI355X kernel written in HIP

```python
import math
import jax, jax.numpy as jnp
from jax import lax
import numpy as np

D_MODEL = 1024
BATCH = 1
SEQ = 16384
DEPTH = 4
DEC_BATCH = 16
DEC_SEQ = 32
PAST_LEN = 1024

CHUNK = 64
N_EVEN = (DEPTH + 1) // 2
N_ODD = DEPTH // 2
H_A = 8
DA = 64
VA = 2 * DA
WA = H_A * VA
H_B = 8
DH_B = 128
WB = H_B * DH_B
D_RNN = 2 * D_MODEL
H_C = 16
BW = D_RNN // H_C
CONV_W = 4
C_RG = 8.0
QB = 128
EPS = 1e-6

kernel_name = 'hybrid_streaming_diffattn_mlstm_rglru_step'


def rmsnorm(x, w):
    xf = x.astype(jnp.float32)
    y = xf * lax.rsqrt(jnp.mean(xf * xf, axis=-1, keepdims=True) + EPS)
    return (y * w.astype(jnp.float32)).astype(x.dtype)


def adaln(x, c, norm_w, w_ada, b_ada):
    mod = jax.nn.silu(c) @ w_ada + b_ada
    shift, scale, gate = jnp.split(mod, 3, axis=-1)
    h = rmsnorm(x, norm_w) * (1 + scale[:, None, :]) + shift[:, None, :]
    return h, gate[:, None, :]


def diff_weights(s, lam):
    p = jax.nn.softmax(s, axis=-1)
    return p[:, :, 0] - lam * p[:, :, 1]


def diff_attn_prompt(q, k, v, lam):
    B, S = q.shape[:2]
    nq = S // QB
    key_chunk = jnp.arange(S) // CHUNK
    q_blocks = q.reshape(B, nq, QB, H_A, 2, DA).swapaxes(0, 1)
    starts = jnp.arange(nq) * QB

    def block(args):
        qb, start = args
        s = jnp.einsum('bqhcd,bkhcd->bhcqk', qb, k).astype(jnp.float32) * DA ** -0.5
        q_chunk = (start + jnp.arange(QB)) // CHUNK
        s = jnp.where(key_chunk[None, :] <= q_chunk[:, None], s, -jnp.inf)
        a = diff_weights(s, lam).astype(v.dtype)
        return jnp.einsum('bhqk,bkhe->bqhe', a, v)

    o = lax.map(block, (q_blocks, starts))
    return o.swapaxes(0, 1).reshape(B, S, H_A, VA)


def diff_attn_sample(q, k_all, v_all, lam):
    s = jnp.einsum('bqhcd,bkhcd->bhcqk', q, k_all).astype(jnp.float32) * DA ** -0.5
    a = diff_weights(s, lam).astype(v_all.dtype)
    return jnp.einsum('bhqk,bkhe->bqhe', a, v_all)


def mlstm_chunk(state, q, k, v, ig, lf):
    f32 = jnp.float32
    c0, n0, m0 = (t.astype(f32) for t in state)
    q, k, v = q.astype(f32), k.astype(f32), v.astype(f32)
    L = q.shape[1]
    b = jnp.cumsum(lf.astype(f32), axis=1).transpose(0, 2, 1)
    igt = ig.astype(f32).transpose(0, 2, 1)
    causal = jnp.tril(jnp.ones((L, L), dtype=bool))
    dmat = jnp.where(causal, b[..., :, None] - b[..., None, :] + igt[..., None, :], -jnp.inf)
    m_t = jnp.maximum(b + m0[..., None], jnp.max(dmat, axis=-1))
    w = jnp.exp(dmat - m_t[..., None])
    inter = jnp.exp(b + m0[..., None] - m_t)
    s = jnp.einsum('bthd,bshd->bhts', q, k) * w
    num = (jnp.einsum('bhts,bshe->bthe', s, v)
           + inter.transpose(0, 2, 1)[..., None] * jnp.einsum('bthd,bhde->bthe', q, c0))
    den = jnp.sum(s, axis=-1) + inter * jnp.einsum('bthd,bhd->bht', q, n0)
    denom = jnp.maximum(jnp.abs(den), jnp.exp(-m_t)).transpose(0, 2, 1)[..., None]
    h = num / denom
    b_last = b[..., -1]
    m_last = m_t[..., -1]
    ws = jnp.exp(b_last[..., None] - b + igt - m_last[..., None])
    decay = jnp.exp(b_last + m0 - m_last)
    c_new = decay[..., None, None] * c0 + jnp.einsum('bhs,bshd,bshe->bhde', ws, k, v)
    n_new = decay[..., None] * n0 + jnp.einsum('bhs,bshd->bhd', ws, k)
    return (c_new, n_new, m_last), h


def mlstm_prompt(q, k, v, ig, lf):
    B, S, H, Dh = q.shape
    nc = S // CHUNK

    def to_chunks(t):
        return t.reshape((B, nc, CHUNK) + t.shape[2:]).swapaxes(0, 1)

    init = (jnp.zeros((B, H, Dh, Dh), jnp.float32), jnp.zeros((B, H, Dh), jnp.float32),
            jnp.zeros((B, H), jnp.float32))

    def step(state, xs):
        return mlstm_chunk(state, *xs)

    state, h = lax.scan(step, init, (to_chunks(q), to_chunks(k), to_chunks(v), to_chunks(ig), to_chunks(lf)))
    return state, h.swapaxes(0, 1).reshape(B, S, H, Dh)


def causal_conv(xr, buf, w, b):
    T = xr.shape[1]
    xpad = jnp.concatenate([buf.astype(xr.dtype), xr], axis=1)
    y = sum(xpad[:, j:j + T] * w[j] for j in range(CONV_W)) + b
    return y, xpad[:, -(CONV_W - 1):]


def rglru(xc, wa, ba, wx, bx, lam, h0):
    f32 = jnp.float32
    B, T, _ = xc.shape
    xf = xc.astype(f32)
    xh = xf.reshape(B, T, H_C, BW)
    r = jax.nn.sigmoid(jnp.einsum('bthi,hij->bthj', xh, wa.astype(f32)).reshape(B, T, D_RNN) + ba.astype(f32))
    i = jax.nn.sigmoid(jnp.einsum('bthi,hij->bthj', xh, wx.astype(f32)).reshape(B, T, D_RNN) + bx.astype(f32))
    log_a = -C_RG * jax.nn.softplus(-lam.astype(f32)) * r
    a = jnp.exp(log_a)
    u = jnp.sqrt(-jnp.expm1(2.0 * log_a)) * (i * xf)
    u = u.at[:, 0].add(a[:, 0] * h0.astype(f32))
    _, hs = lax.associative_scan(lambda l, rr: (l[0] * rr[0], rr[0] * l[1] + rr[1]), (a, u), axis=1)
    return hs


def even_layer(h, li, e, p, cache):
    B, T, _ = h.shape
    sizes = (WA, WA, WA, WA, WB, WB, WB, WB, WB, H_B, H_B)
    proj = h @ p['w_in_even'][e]
    qa, ka, va, za, qb, kb, vb, ob, zb, ig, fg = jnp.split(proj, np.cumsum(sizes)[:-1].tolist(), axis=-1)
    qa = qa.reshape(B, T, H_A, 2, DA)
    ka = ka.reshape(B, T, H_A, 2, DA)
    va = va.reshape(B, T, H_A, VA)
    lam_init = 0.8 - 0.6 * math.exp(-0.3 * li)
    f32 = jnp.float32
    lam = (jnp.exp(jnp.sum(p['lambda_q1'][e].astype(f32) * p['lambda_k1'][e].astype(f32)))
           - jnp.exp(jnp.sum(p['lambda_q2'][e].astype(f32) * p['lambda_k2'][e].astype(f32))) + lam_init)
    if cache is None:
        oa = diff_attn_prompt(qa, ka, va, lam)
    else:
        k_past, v_past, c0, n0, m0 = cache
        oa = diff_attn_sample(qa, jnp.concatenate([k_past, ka], axis=1),
                              jnp.concatenate([v_past, va], axis=1), lam)
    oa = (rmsnorm(oa, p['subln_w'][e]) * (1.0 - lam_init)).reshape(B, T, WA) * jax.nn.silu(za)
    qb = qb.reshape(B, T, H_B, DH_B)
    kb = kb.reshape(B, T, H_B, DH_B) * DH_B ** -0.5
    vb = vb.reshape(B, T, H_B, DH_B)
    bg = p['b_gates_even'][e]
    ig = ig + bg[:H_B]
    lf = jax.nn.log_sigmoid((fg + bg[H_B:]).astype(f32))
    if cache is None:
        (c_new, n_new, m_new), hb = mlstm_prompt(qb, kb, vb, ig, lf)
    else:
        (c_new, n_new, m_new), hb = mlstm_chunk((c0, n0, m0), qb, kb, vb, ig, lf)
    hb = jax.nn.sigmoid(ob.astype(f32)).reshape(B, T, H_B, DH_B) * hb
    hb = rmsnorm(hb, p['mh_norm_w'][e].reshape(H_B, DH_B)).astype(h.dtype).reshape(B, T, WB)
    hb = hb * jax.nn.silu(zb)
    y = jnp.concatenate([oa, hb], axis=-1) @ p['w_out_even'][e]
    return y, (ka, va, c_new, n_new, m_new)


def odd_layer(h, o, p, cache):
    B, T, _ = h.shape
    xr, zr = jnp.split(h @ p['w_in_odd'][o], 2, axis=-1)
    if cache is None:
        buf = jnp.zeros((B, CONV_W - 1, D_RNN), h.dtype)
        h0 = jnp.zeros((B, D_RNN), jnp.float32)
    else:
        buf, h0 = cache
    xc, conv_state = causal_conv(xr, buf, p['conv_w'][o], p['conv_b'][o])
    hr = rglru(xc, p['rg_wa'][o], p['rg_ba'][o], p['rg_wx'][o], p['rg_bx'][o], p['rg_lambda'][o], h0)
    y = (hr.astype(h.dtype) * jax.nn.silu(zr)) @ p['w_out_odd'][o]
    return y, (conv_state, hr[:, -1])


def trunk(x, c, p, cache):
    even_states, odd_states = [], []
    for li in range(DEPTH):
        h, gate = adaln(x, c, p['norm_w'][li], p['w_ada'][li], p['b_ada'][li])
        if li % 2 == 0:
            e = li // 2
            lc = None if cache is None else (cache['k'][e], cache['v'][e], cache['c'][e], cache['n'][e], cache['m'][e])
            y, st = even_layer(h, li, e, p, lc)
            even_states.append(st)
        else:
            o = li // 2
            lc = None if cache is None else (cache['conv'][o], cache['h'][o])
            y, st = odd_layer(h, o, p, lc)
            odd_states.append(st)
        x = x + gate * y.astype(x.dtype)
    ev = [jnp.stack(s) for s in zip(*even_states)]
    od = [jnp.stack(s) for s in zip(*odd_states)]
    return rmsnorm(x, p['final_w']), ev, od


def setup_inputs(seed: int = 0) -> dict:
    key = jax.random.key(seed)
    ks = iter(jax.random.split(key, 48))
    D = D_MODEL

    def nrm(shape, s):
        return jax.random.normal(next(ks), shape, jnp.float32) * s

    u = jax.random.uniform(next(ks), (N_ODD, D_RNN), jnp.float32, 0.9, 0.999)
    sg = u ** (1.0 / C_RG)
    return {
        'x_prompt': nrm((BATCH, SEQ, D), 1.0),
        'x_sample': nrm((DEC_BATCH, DEC_SEQ, D), 1.0),
        'c_prompt': nrm((BATCH, D), 1.0),
        'c_sample': nrm((DEC_BATCH, D), 1.0),
        'cache_k': nrm((N_EVEN, DEC_BATCH, PAST_LEN, H_A, 2, DA), 1.0),
        'cache_v': nrm((N_EVEN, DEC_BATCH, PAST_LEN, H_A, VA), 1.0),
        'state_mlstm_c': nrm((N_EVEN, DEC_BATCH, H_B, DH_B, DH_B), 0.1),
        'state_mlstm_n': nrm((N_EVEN, DEC_BATCH, H_B, DH_B), 0.1),
        'state_mlstm_m': nrm((N_EVEN, DEC_BATCH, H_B), 0.5),
        'state_conv': nrm((N_ODD, DEC_BATCH, CONV_W - 1, D_RNN), 1.0),
        'state_rglru': nrm((N_ODD, DEC_BATCH, D_RNN), 0.5),
        'norm_w': 1.0 + nrm((DEPTH, D), 0.02),
        'w_ada': nrm((DEPTH, D, 3 * D), 0.5 * D ** -0.5),
        'b_ada': nrm((DEPTH, 3 * D), 0.01),
        'w_in_even': nrm((N_EVEN, D, 4 * WA + 5 * WB + 2 * H_B), D ** -0.5),
        'b_gates_even': jnp.concatenate([nrm((N_EVEN, H_B), 0.1),
                                         jnp.broadcast_to(jnp.linspace(3.0, 6.0, H_B), (N_EVEN, H_B)) + nrm((N_EVEN, H_B), 0.1)], axis=-1),
        'lambda_q1': nrm((N_EVEN, DA), 0.1),
        'lambda_k1': nrm((N_EVEN, DA), 0.1),
        'lambda_q2': nrm((N_EVEN, DA), 0.1),
        'lambda_k2': nrm((N_EVEN, DA), 0.1),
        'subln_w': 1.0 + nrm((N_EVEN, VA), 0.02),
        'mh_norm_w': 1.0 + nrm((N_EVEN, WB), 0.02),
        'w_out_even': nrm((N_EVEN, WA + WB, D), (WA + WB) ** -0.5),
        'w_in_odd': nrm((N_ODD, D, 2 * D_RNN), D ** -0.5),
        'conv_w': nrm((N_ODD, CONV_W, D_RNN), CONV_W ** -0.5),
        'conv_b': nrm((N_ODD, D_RNN), 0.01),
        'rg_wa': nrm((N_ODD, H_C, BW, BW), BW ** -0.5),
        'rg_ba': nrm((N_ODD, D_RNN), 0.01),
        'rg_wx': nrm((N_ODD, H_C, BW, BW), BW ** -0.5),
        'rg_bx': nrm((N_ODD, D_RNN), 0.01),
        'rg_lambda': jnp.log(sg) - jnp.log1p(-sg),
        'w_out_odd': nrm((N_ODD, D_RNN, D), D_RNN ** -0.5),
        'final_w': 1.0 + nrm((D,), 0.02),
    }


def reference(x_prompt, x_sample, c_prompt, c_sample, cache_k, cache_v, state_mlstm_c, state_mlstm_n,
              state_mlstm_m, state_conv, state_rglru, norm_w, w_ada, b_ada, w_in_even, b_gates_even,
              lambda_q1, lambda_k1, lambda_q2, lambda_k2, subln_w, mh_norm_w, w_out_even, w_in_odd,
              conv_w, conv_b, rg_wa, rg_ba, rg_wx, rg_bx, rg_lambda, w_out_odd, final_w):
    p = dict(norm_w=norm_w, w_ada=w_ada, b_ada=b_ada, w_in_even=w_in_even, b_gates_even=b_gates_even,
             lambda_q1=lambda_q1, lambda_k1=lambda_k1, lambda_q2=lambda_q2, lambda_k2=lambda_k2,
             subln_w=subln_w, mh_norm_w=mh_norm_w, w_out_even=w_out_even, w_in_odd=w_in_odd,
             conv_w=conv_w, conv_b=conv_b, rg_wa=rg_wa, rg_ba=rg_ba, rg_wx=rg_wx, rg_bx=rg_bx,
             rg_lambda=rg_lambda, w_out_odd=w_out_odd, final_w=final_w)
    y_prompt, ev_p, od_p = trunk(x_prompt, c_prompt, p, None)
    k_p, v_p, mc_p, mn_p, mm_p = ev_p
    conv_p, h_p = od_p
    cache = dict(k=cache_k, v=cache_v, c=state_mlstm_c, n=state_mlstm_n, m=state_mlstm_m,
                 conv=state_conv, h=state_rglru)
    y_sample, ev_s, od_s = trunk(x_sample, c_sample, p, cache)
    k_s, v_s, mc_s, mn_s, mm_s = ev_s
    conv_s, h_s = od_s
    return (y_prompt, y_sample, k_p, v_p, mc_p, mn_p, mm_p, conv_p, h_p,
            k_s, v_s, mc_s, mn_s, mm_s, conv_s, h_s)
```

```cpp
#include <hip/hip_runtime.h>
#include <hip/hip_cooperative_groups.h>
#include <cstdio>
#include <cstring>
namespace cg = cooperative_groups;

#ifndef MEGA
#define MEGA 1
#endif
#ifndef PM
#define PM 0xffff
#endif
#ifndef REP
#define REP 0
#endif
#ifndef REPA
#define REPA 0
#endif

#define LAS __attribute__((address_space(3)))
typedef unsigned short u16;
typedef unsigned int u32;
using bf16x8 = __attribute__((ext_vector_type(8))) short;
using f32x4 = __attribute__((ext_vector_type(4))) float;
using u32x4 = __attribute__((ext_vector_type(4))) unsigned int;
using u32x2 = __attribute__((ext_vector_type(2))) unsigned int;

#define NT 16896
#define SP 16384
#define NTHR 256
#define SMEM_BYTES 73728
#define NSLOT 272
#define PCC 2112
#define PWO 2112

struct TDesc { const float* src; u16* dst; int K, N, Npad, nb, tstart, per, ldd, pad; };

struct Params {
  const float* in[33];
  float *y, *kp, *vp, *mcp, *mnp, *mmp, *convp, *rgp, *ks, *vs, *mcs, *mns, *mms, *convs, *rgs;
  u16 *HC, *PROJ, *UST;
  u16 *Wie[2], *Woe[2], *Wio[2], *Woo[2], *Wra[2], *Wrx[2];
  float *MODS, *GATES, *AB, *NST, *MST, *AGG;
  unsigned* BAR;
  TDesc td[12];
  int ntr;
  int pad;
};

typedef const __attribute__((address_space(4))) Params& PRM;
typedef const __attribute__((address_space(4))) Params* PRMP;
__device__ __forceinline__ float bf2f(u16 h) { return __uint_as_float(((u32)h) << 16); }
__device__ __forceinline__ float bflo(u32 w) { return __uint_as_float(w << 16); }
__device__ __forceinline__ float bfhi(u32 w) { return __uint_as_float(w & 0xffff0000u); }
typedef __bf16 bf2_t __attribute__((ext_vector_type(2)));
typedef float f2_t __attribute__((ext_vector_type(2)));
__device__ __forceinline__ u32 pack2(float a, float b) {
  f2_t v = {a, b};
  bf2_t r = __builtin_convertvector(v, bf2_t);
  return __builtin_bit_cast(u32, r);
}
__device__ __forceinline__ u16 f2bf(float a) { return (u16)(pack2(a, 0.f) & 0xffffu); }
__device__ __forceinline__ f32x4 mfma16(bf16x8 a, bf16x8 b, f32x4 c) {
  return __builtin_amdgcn_mfma_f32_16x16x32_bf16(a, b, c, 0, 0, 0);
}
__device__ __forceinline__ bf16x8 mk8(u32 a, u32 b, u32 c, u32 d) {
  u32x4 v = {a, b, c, d};
  return __builtin_bit_cast(bf16x8, v);
}
__device__ __forceinline__ float red16_max(float v) {
  v = fmaxf(v, __shfl_xor(v, 16));
  v = fmaxf(v, __shfl_xor(v, 32));
  return v;
}
__device__ __forceinline__ float red16_sum(float v) {
  v += __shfl_xor(v, 16);
  v += __shfl_xor(v, 32);
  return v;
}
__device__ __forceinline__ float wave_sum(float v) {
#pragma unroll
  for (int d = 1; d < 64; d <<= 1) v += __shfl_xor(v, d);
  return v;
}
__device__ __forceinline__ float wave_max(float v) {
#pragma unroll
  for (int d = 1; d < 64; d <<= 1) v = fmaxf(v, __shfl_xor(v, d));
  return v;
}
__device__ __forceinline__ float rcpf_(float x) { return __builtin_amdgcn_rcpf(x); }
__device__ __forceinline__ float sigmoidf_(float x) { return rcpf_(1.f + __expf(-x)); }
__device__ __forceinline__ float siluf_(float x) { return x * rcpf_(1.f + __expf(-x)); }
__device__ __forceinline__ int tid_opaque(int wv) { int t = wv * 64 + (int)__lane_id(); asm volatile("" : "+v"(t)); return t & 255; }
__device__ __forceinline__ int vpos(int cc) { return (cc >> 2) * 32 + (cc & 1) * 16 + ((cc >> 1) & 1) * 4; }
__device__ __forceinline__ void vstore(u16* row, int cc, u32x4 v) {
  const int pa = vpos(cc);
  *(u32x2*)(row + pa) = u32x2{v[0], v[1]};
  *(u32x2*)(row + pa + 8) = u32x2{v[2], v[3]};
}
__device__ __forceinline__ int seqid(int tok) { return tok < SP ? 0 : 1 + ((tok - SP) >> 5); }

__device__ void transpose_tile(int wv, PRM p, char* smem, int t) {
  int di = 0;
#pragma unroll
  for (int i = 1; i < 12; ++i) if (t >= p.td[i].tstart) di = i;
  TDesc d;
  d.src = p.td[di].src; d.dst = p.td[di].dst; d.K = p.td[di].K; d.N = p.td[di].N; d.Npad = p.td[di].Npad;
  d.nb = p.td[di].nb; d.tstart = p.td[di].tstart; d.per = p.td[di].per; d.ldd = p.td[di].ldd;
  int r = t - d.tstart;
  int batch = r / d.per; r -= batch * d.per;
  const int tk = d.K >> 6;
  const int kt = r % tk, nt = r / tk;
  const float* src = d.src + (size_t)batch * d.K * d.N;
  u16* dst = d.dst + (size_t)batch * d.Npad * d.ldd;
  float* tr = (float*)smem;
  const int tid = tid_opaque(wv);
  const int k0 = kt * 64, n0 = nt * 64;
  {
    const int rr = tid >> 4, c4 = tid & 15;
#pragma unroll
    for (int i = 0; i < 4; ++i) {
      const int k = rr + 16 * i;
      const int n = n0 + c4 * 4;
      float4 v = make_float4(0.f, 0.f, 0.f, 0.f);
      if (n < d.N) v = *(const float4*)(src + (size_t)(k0 + k) * d.N + n);
      tr[k * 65 + c4 * 4 + 0] = v.x; tr[k * 65 + c4 * 4 + 1] = v.y;
      tr[k * 65 + c4 * 4 + 2] = v.z; tr[k * 65 + c4 * 4 + 3] = v.w;
    }
  }
  __syncthreads();
  {
    const int n = tid >> 2, kq = tid & 3;
    u32 w[8];
#pragma unroll
    for (int j = 0; j < 8; ++j)
      w[j] = pack2(tr[(kq * 16 + 2 * j) * 65 + n], tr[(kq * 16 + 2 * j + 1) * 65 + n]);
    u16* o = dst + (size_t)(n0 + n) * d.ldd + k0 + kq * 16;
    *(u32x4*)(o) = u32x4{w[0], w[1], w[2], w[3]};
    *(u32x4*)(o + 8) = u32x4{w[4], w[5], w[6], w[7]};
  }
  __syncthreads();
}

__device__ void adaln_item(int wv, PRM p, char* smem, int it) {
  const int l = it / 96, jb = it % 96;
  const int tid = tid_opaque(wv), col = tid & 31, kg = tid >> 5;
  float* sc = (float*)smem;
  float* red = sc + 17 * 512;
  const float* W = p.in[12] + (size_t)l * 1024 * 3072 + jb * 32 + col;
  float acc[17];
#pragma unroll
  for (int b = 0; b < 17; ++b) acc[b] = 0.f;
  for (int half = 0; half < 2; ++half) {
    __syncthreads();
    for (int i = tid; i < 17 * 512; i += NTHR) {
      const int b = i >> 9, k = (i & 511) + half * 512;
      const float c = (b == 0) ? p.in[2][k] : p.in[3][(b - 1) * 1024 + k];
      sc[i] = siluf_(c);
    }
    __syncthreads();
#pragma unroll 1
    for (int k0 = 0; k0 < 64; k0 += 16) {
      float wv16[16];
#pragma unroll
      for (int kk = 0; kk < 16; ++kk) wv16[kk] = W[(size_t)(half * 512 + kg * 64 + k0 + kk) * 3072];
#pragma unroll
      for (int kk = 0; kk < 16; ++kk) {
        const int kl = kg * 64 + k0 + kk;
#pragma unroll
        for (int b = 0; b < 17; ++b) acc[b] += sc[b * 512 + kl] * wv16[kk];
      }
    }
  }
#pragma unroll
  for (int b = 0; b < 17; ++b) red[(kg * 17 + b) * 32 + col] = acc[b];
  __syncthreads();
  for (int i = tid; i < 17 * 32; i += NTHR) {
    const int b = i >> 5, c = i & 31;
    float v = 0.f;
#pragma unroll
    for (int g = 0; g < 8; ++g) v += red[(g * 17 + b) * 32 + c];
    p.MODS[(size_t)(l * 17 + b) * 3072 + jb * 32 + c] = v + p.in[13][l * 3072 + jb * 32 + c];
  }
  __syncthreads();
}

__device__ void prologue_phase(int wv, PRM p, char* smem) {
  const int total = p.ntr + 384;
  for (int it = blockIdx.x; it < total; it += gridDim.x) {
    if (it < 384) adaln_item(wv, p, smem, it);
    else transpose_tile(wv, p, smem, it - 384);
  }
}

__device__ void norm_phase(int wv, PRM p, int li) {
  const int tid = tid_opaque(wv);
  const int wave = tid >> 6, lane = tid & 63;
  for (int row = blockIdx.x * 4 + wave; row < NT; row += gridDim.x * 4) {
    const float* xr = (li == 0) ? (row < SP ? p.in[0] + (size_t)row * 1024 : p.in[1] + (size_t)(row - SP) * 1024)
                                : p.y + (size_t)row * 1024;
    float4 v[4];
    float ss = 0.f;
#pragma unroll
    for (int i = 0; i < 4; ++i) {
      v[i] = *(const float4*)(xr + lane * 4 + i * 256);
      ss += v[i].x * v[i].x + v[i].y * v[i].y + v[i].z * v[i].z + v[i].w * v[i].w;
    }
    ss = wave_sum(ss);
    const float rstd = rsqrtf(ss * (1.f / 1024.f) + 1e-6f);
    if (li < 4) {
      const int b = seqid(row);
      const float* shift = p.MODS + (size_t)(li * 17 + b) * 3072;
      const float* scale = shift + 1024;
      const float* nw = p.in[11] + li * 1024;
#pragma unroll
      for (int i = 0; i < 4; ++i) {
        const int k = lane * 4 + i * 256;
        const float4 w4 = *(const float4*)(nw + k);
        const float4 s4 = *(const float4*)(scale + k);
        const float4 h4 = *(const float4*)(shift + k);
        const float a0 = v[i].x * rstd * w4.x * (1.f + s4.x) + h4.x;
        const float a1 = v[i].y * rstd * w4.y * (1.f + s4.y) + h4.y;
        const float a2 = v[i].z * rstd * w4.z * (1.f + s4.z) + h4.z;
        const float a3 = v[i].w * rstd * w4.w * (1.f + s4.w) + h4.w;
        *(u32x2*)(p.HC + (size_t)row * 1024 + k) = u32x2{pack2(a0, a1), pack2(a2, a3)};
      }
    } else {
      const float* fw = p.in[32];
#pragma unroll
      for (int i = 0; i < 4; ++i) {
        const int k = lane * 4 + i * 256;
        const float4 w4 = *(const float4*)(fw + k);
        float4 o;
        o.x = v[i].x * rstd * w4.x; o.y = v[i].y * rstd * w4.y;
        o.z = v[i].z * rstd * w4.z; o.w = v[i].w * rstd * w4.w;
        *(float4*)(p.y + (size_t)row * 1024 + k) = o;
      }
    }
  }
}

#define EPI_INEVEN 0
#define EPI_OUT 1
#define EPI_INODD 2

template <int EPI>
__device__ __forceinline__ void gemm_store(PRM p, int li, int tb, int col, f32x4 v) {
  if (EPI == EPI_INEVEN) {
    const int ei = li >> 1;
    const int region = col >> 10, c = col & 1023;
    if (region == 9) {
      if (c < 16) {
#pragma unroll
        for (int j = 0; j < 4; ++j) p.GATES[(size_t)(tb + j) * 16 + c] = v[j];
      }
      return;
    }
    u16* reg = p.PROJ + (size_t)region * NT * 1024;
    if (region == 2 || region == 6) {
      const int key = tb & 63;
      const int pos = (key >> 5) * 32 + ((key >> 2) & 3) * 8 + ((key >> 4) & 1) * 4;
      *(u32x2*)(reg + (size_t)c * NT + (tb & ~63) + pos) = u32x2{pack2(v[0], v[1]), pack2(v[2], v[3])};
    } else {
      const float sc = (region == 5) ? 0.08838834764831845f : 1.f;
#pragma unroll
      for (int j = 0; j < 4; ++j) reg[(size_t)(tb + j) * 1024 + c] = f2bf(v[j] * sc);
    }
    if (region == 1 || region == 2) {
      float* op = (region == 1) ? p.kp : p.vp;
      float* os = (region == 1) ? p.ks : p.vs;
#pragma unroll
      for (int j = 0; j < 4; ++j) {
        const int tok = tb + j;
        if (tok < SP) op[((size_t)ei * SP + tok) * 1024 + c] = v[j];
        else os[((size_t)ei * 512 + (tok - SP)) * 1024 + c] = v[j];
      }
    }
  } else if (EPI == EPI_OUT) {
#pragma unroll
    for (int j = 0; j < 4; ++j) {
      const int tok = tb + j;
      const int b = seqid(tok);
      const float g = p.MODS[(size_t)(li * 17 + b) * 3072 + 2048 + col];
      float xres;
      if (li == 0) xres = (tok < SP) ? p.in[0][(size_t)tok * 1024 + col] : p.in[1][(size_t)(tok - SP) * 1024 + col];
      else xres = p.y[(size_t)tok * 1024 + col];
      p.y[(size_t)tok * 1024 + col] = xres + g * v[j];
    }
  } else {
#pragma unroll
    for (int j = 0; j < 4; ++j) p.PROJ[(size_t)(tb + j) * 4096 + col] = f2bf(v[j]);
  }
}

template <int EPI, int BM>
__device__ void gemm_phase(int wv, PRM p, char* smem, const u16* __restrict__ A, int lda,
                           const u16* __restrict__ Bt, int ldb, int K, int ntn, int li) {
  constexpr int MT = BM / 32;
  constexpr int NA = BM / 64;
  constexpr int STG = (BM + 128) * 64;
  constexpr int NM = NT / BM;
  const int tid = tid_opaque(wv), lane = tid & 63, w = tid >> 6;
  const int wr = w >> 1, wc = w & 1, l15 = lane & 15, q4 = lane >> 4;
  const int total = NM * ntn;
  const int nloc = gridDim.x >> 3;
  const int nk = K >> 5;
  const int gk = (0x1320 >> ((lane >> 4) * 4)) & 3;
  const int dsw = ((lane & 3) ^ gk) * 8;
  const int fk = (0x1320 >> ((l15 >> 2) * 4)) & 3;
  const int po = (q4 ^ fk) * 16;
  for (int it = 0;; ++it) {
    const int base = it * 8 * nloc;
    if (base >= total) break;
    const int Lidx = (it * 8 + (blockIdx.x & 7)) * nloc + (blockIdx.x >> 3);
    if (Lidx >= total) continue;
    const int g = Lidx / (8 * ntn), r = Lidx - g * 8 * ntn;
    const int gsz = min(8, NM - g * 8);
    const int tm = g * 8 + r % gsz, tn = r / gsz;
    const int m0 = tm * BM, n0 = tn * 128;
    f32x4 acc[MT][4];
#pragma unroll
    for (int m = 0; m < MT; ++m)
#pragma unroll
      for (int n = 0; n < 4; ++n) acc[m][n] = f32x4{0.f, 0.f, 0.f, 0.f};
    const u16* Ag = A + (size_t)(m0 + w * NA * 16 + (lane >> 2)) * lda + dsw;
    const u16* Bg = Bt + (size_t)(n0 + w * 32 + (lane >> 2)) * ldb + dsw;
#define G_DMA(KT, ST)                                                                              \
  {                                                                                                \
    _Pragma("unroll") for (int i = 0; i < NA; ++i)                                                 \
      __builtin_amdgcn_global_load_lds((const unsigned*)(Ag + (size_t)(i * 16) * lda + (KT) * 32), \
          (LAS unsigned*)(smem + (ST) * STG + (w * NA + i) * 1024 + lane * 16), 16, 0, 0);         \
    _Pragma("unroll") for (int i = 0; i < 2; ++i)                                                  \
      __builtin_amdgcn_global_load_lds((const unsigned*)(Bg + (size_t)(i * 16) * ldb + (KT) * 32),   \
          (LAS unsigned*)(smem + (ST) * STG + BM * 64 + (w * 2 + i) * 1024 + lane * 16), 16, 0, 0); \
  }
    asm volatile("s_waitcnt vmcnt(0)" ::: "memory");
    __syncthreads();
    constexpr int NS = (BM == 256) ? 3 : 4;
    G_DMA(0, 0)
    G_DMA(1, 1)
    if (NS == 4) { G_DMA(2, 2) }
    int st = 0;
    for (int kt = 0; kt < nk; ++kt) {
      const int rem = nk - 1 - kt;
      if (BM == 256) {
        if (rem >= 1) asm volatile("s_waitcnt vmcnt(6)" ::: "memory");
        else asm volatile("s_waitcnt vmcnt(0)" ::: "memory");
      } else {
        if (rem >= 2) asm volatile("s_waitcnt vmcnt(8)" ::: "memory");
        else if (rem == 1) asm volatile("s_waitcnt vmcnt(4)" ::: "memory");
        else asm volatile("s_waitcnt vmcnt(0)" ::: "memory");
      }
      __builtin_amdgcn_s_barrier();
      if (kt + NS - 1 < nk) {
        const int s2 = (st >= 1) ? st - 1 : NS - 1;
        G_DMA(kt + NS - 1, s2)
      }
      __builtin_amdgcn_sched_barrier(0);
      const char* cA = smem + st * STG + (wr * (BM / 2) + l15) * 64 + po;
      const char* cB = smem + st * STG + BM * 64 + (wc * 64 + l15) * 64 + po;
      bf16x8 af[MT], bfr[4];
      const unsigned aA = (unsigned)(size_t)(LAS const char*)cA, aB = (unsigned)(size_t)(LAS const char*)cB;
#pragma unroll
      for (int m = 0; m < MT; ++m)
        asm volatile("ds_read_b128 %0, %1 offset:%2" : "=v"(af[m]) : "v"(aA), "i"(m * 16 * 64));
#pragma unroll
      for (int n = 0; n < 4; ++n)
        asm volatile("ds_read_b128 %0, %1 offset:%2" : "=v"(bfr[n]) : "v"(aB), "i"(n * 16 * 64));
      if (MT == 8)
        asm volatile("s_waitcnt lgkmcnt(0)" : "+v"(af[0]), "+v"(af[1]), "+v"(af[2]), "+v"(af[3]), "+v"(af[MT - 4]), "+v"(af[MT - 3]),
                     "+v"(af[MT - 2]), "+v"(af[MT - 1]), "+v"(bfr[0]), "+v"(bfr[1]), "+v"(bfr[2]), "+v"(bfr[3]));
      else
        asm volatile("s_waitcnt lgkmcnt(0)" : "+v"(af[0]), "+v"(af[1]), "+v"(af[2]), "+v"(af[3]), "+v"(bfr[0]), "+v"(bfr[1]),
                     "+v"(bfr[2]), "+v"(bfr[3]));

#pragma unroll
      for (int m = 0; m < MT; ++m)
#pragma unroll
        for (int n = 0; n < 4; ++n) acc[m][n] = mfma16(af[m], bfr[n], acc[m][n]);

      st = (st == NS - 1) ? 0 : st + 1;
    }
#undef G_DMA
#pragma unroll
    for (int m = 0; m < MT; ++m)
#pragma unroll
      for (int n = 0; n < 4; ++n)
        gemm_store<EPI>(p, li, m0 + wr * (BM / 2) + m * 16 + q4 * 4, n0 + wc * 64 + n * 16 + l15, acc[m][n]);
  }
}

template <int NQT, bool SAMPLE>
__device__ void attn_item(int wv, PRM p, char* smem, int ei, int h, int idx, float lam, float lam_init) {
  const int tid = tid_opaque(wv), lane = tid & 63, w = tid >> 6;
  const int c = w & 1, qh = w >> 1, l15 = lane & 15, q4 = lane >> 4;
  u16* sK = (u16*)smem;
  u16* sV = sK + 64 * 136;
  const u16* Qg = p.PROJ;
  const u16* Kg = p.PROJ + (size_t)1 * NT * 1024;
  const u16* Vtg = p.PROJ + (size_t)2 * NT * 1024;
  const u16* Zg = p.PROJ + (size_t)3 * NT * 1024;
  constexpr int QW = NQT * 16;
  const int tokq0 = SAMPLE ? SP + idx * 32 : idx * 64;
  u16* sQ = sV + 128 * 72;
#pragma unroll
  for (int i = 0; i < NQT * 2; ++i) {
    const int id = tid + i * 256;
    *(u32x4*)(sQ + (id >> 4) * 136 + (id & 15) * 8) =
        *(const u32x4*)(Qg + (size_t)(tokq0 + (id >> 4)) * 1024 + h * 128 + (id & 15) * 8);
  }
  f32x4 o[8][NQT];
  float m_run[NQT], l_run[NQT];
#pragma unroll
  for (int qt = 0; qt < NQT; ++qt) {
    m_run[qt] = -1e30f; l_run[qt] = 0.f;
#pragma unroll
    for (int et = 0; et < 8; ++et) o[et][qt] = f32x4{0.f, 0.f, 0.f, 0.f};
  }
  const int nkt = SAMPLE ? 17 : idx + 1;
  const float SC = 0.125f * 1.4426950408889634f;
  u32x4 rk[4], rv[4];
  float4 fk[8], fv[8];
  if (SAMPLE) {
    const float* ck = p.in[4] + ((size_t)(ei * 16 + idx) * 1024) * 1024 + h * 128;
    const float* cv = p.in[5] + ((size_t)(ei * 16 + idx) * 1024) * 1024 + h * 128;
#pragma unroll
    for (int i = 0; i < 8; ++i) {
      const int id = tid + i * 256;
      fk[i] = *(const float4*)(ck + (size_t)(id >> 5) * 1024 + (id & 31) * 4);
      fv[i] = *(const float4*)(cv + (size_t)(id & 63) * 1024 + (id >> 6) * 4);
    }
  }
  if (!SAMPLE) {
#pragma unroll
    for (int i = 0; i < 4; ++i) {
      const int id = tid + i * 256;
      rk[i] = *(const u32x4*)(Kg + (size_t)(0 * 64 + (id >> 4)) * 1024 + h * 128 + (id & 15) * 8);
      rv[i] = *(const u32x4*)(Vtg + (size_t)(h * 128 + (id >> 3)) * NT + 0 * 64 + (id & 7) * 8);
    }
  }
  for (int kt = 0; kt < nkt; ++kt) {
    __syncthreads();
    int nmt = 4;
    if (!SAMPLE) {
#pragma unroll
      for (int i = 0; i < 4; ++i) {
        const int id = tid + i * 256;
        *(u32x4*)(sK + (id >> 4) * 136 + (id & 15) * 8) = rk[i];
        *(u32x4*)(sV + (id >> 3) * 72 + (id & 7) * 8) = rv[i];
      }
    } else {
      if (kt < 16) {
#pragma unroll
        for (int i = 0; i < 8; ++i) {
          const int id = tid + i * 256;
          const int key = id >> 5, c4 = id & 31;
          *(u32x2*)(sK + key * 136 + c4 * 4) = u32x2{pack2(fk[i].x, fk[i].y), pack2(fk[i].z, fk[i].w)};
        }
#pragma unroll
        for (int i = 0; i < 8; ++i) {
          const int id = tid + i * 256;
          const int key = id & 63, c4 = id >> 6;
          const int kp = (key >> 5) * 32 + ((key >> 2) & 3) * 8 + ((key >> 4) & 1) * 4 + (key & 3);
          sV[(c4 * 4 + 0) * 72 + kp] = f2bf(fv[i].x);
          sV[(c4 * 4 + 1) * 72 + kp] = f2bf(fv[i].y);
          sV[(c4 * 4 + 2) * 72 + kp] = f2bf(fv[i].z);
          sV[(c4 * 4 + 3) * 72 + kp] = f2bf(fv[i].w);
        }
      } else {
        nmt = 2;
        const int tk0 = SP + idx * 32;
#pragma unroll
        for (int i = 0; i < 2; ++i) {
          const int id = tid + i * 256;
          *(u32x4*)(sK + (id >> 4) * 136 + (id & 15) * 8) =
              *(const u32x4*)(Kg + (size_t)(tk0 + (id >> 4)) * 1024 + h * 128 + (id & 15) * 8);
          *(u32x4*)(sV + (id >> 2) * 72 + (id & 3) * 8) =
              *(const u32x4*)(Vtg + (size_t)(h * 128 + (id >> 2)) * NT + tk0 + (id & 3) * 8);
        }
      }
    }
    __syncthreads();
    if (!SAMPLE) {
      if (kt + 1 < nkt) {
#pragma unroll
        for (int i = 0; i < 4; ++i) {
          const int id = tid + i * 256;
          rk[i] = *(const u32x4*)(Kg + (size_t)((kt + 1) * 64 + (id >> 4)) * 1024 + h * 128 + (id & 15) * 8);
          rv[i] = *(const u32x4*)(Vtg + (size_t)(h * 128 + (id >> 3)) * NT + (kt + 1) * 64 + (id & 7) * 8);
        }
      }
    } else {
      if (kt + 1 < 16) {
        const float* ck = p.in[4] + ((size_t)(ei * 16 + idx) * 1024 + (kt + 1) * 64) * 1024 + h * 128;
        const float* cv = p.in[5] + ((size_t)(ei * 16 + idx) * 1024 + (kt + 1) * 64) * 1024 + h * 128;
#pragma unroll
        for (int i = 0; i < 8; ++i) {
          const int id = tid + i * 256;
          fk[i] = *(const float4*)(ck + (size_t)(id >> 5) * 1024 + (id & 31) * 4);
          fv[i] = *(const float4*)(cv + (size_t)(id & 63) * 1024 + (id >> 6) * 4);
        }
      }
    }
    __builtin_amdgcn_sched_barrier(0);
    f32x4 s[4][NQT];
    bf16x8 kf[4][2];
    bf16x8 qf[NQT][2];
#pragma unroll
    for (int qt = 0; qt < NQT; ++qt)
#pragma unroll
      for (int ks = 0; ks < 2; ++ks)
        qf[qt][ks] = *(const bf16x8*)(sQ + (qh * QW + qt * 16 + l15) * 136 + c * 64 + ks * 32 + q4 * 8);
#pragma unroll
    for (int mt = 0; mt < 4; ++mt)
#pragma unroll
      for (int ks = 0; ks < 2; ++ks)
        kf[mt][ks] = *(const bf16x8*)(sK + (mt * 16 + l15) * 136 + c * 64 + ks * 32 + q4 * 8);
    __builtin_amdgcn_sched_barrier(0);

#pragma unroll
    for (int mt = 0; mt < 4; ++mt)
#pragma unroll
      for (int qt = 0; qt < NQT; ++qt) {
        s[mt][qt] = f32x4{0.f, 0.f, 0.f, 0.f};
        if (mt < nmt) {
#pragma unroll
          for (int ks = 0; ks < 2; ++ks) s[mt][qt] = mfma16(kf[mt][ks], qf[qt][ks], s[mt][qt]);
        }
      }

    __builtin_amdgcn_sched_barrier(0);
    u32 pw[NQT][8];
#pragma unroll
    for (int qt = 0; qt < NQT; ++qt) {
      float mx = -1e30f;
#pragma unroll
      for (int mt = 0; mt < 4; ++mt)
        if (mt < nmt) {
#pragma unroll
          for (int j = 0; j < 4; ++j) mx = fmaxf(mx, s[mt][qt][j]);
        }
      mx = red16_max(mx) * SC;
      const float mnew = fmaxf(m_run[qt], mx);
      const float alpha = __builtin_amdgcn_exp2f(m_run[qt] - mnew);
      m_run[qt] = mnew;
      float psum = 0.f;
#pragma unroll
      for (int mt = 0; mt < 4; ++mt) {
#pragma unroll
        for (int j = 0; j < 4; ++j) {
          float pv = 0.f;
          if (mt < nmt) pv = __builtin_amdgcn_exp2f(s[mt][qt][j] * SC - mnew);
          psum += pv;
          s[mt][qt][j] = pv;
        }
        pw[qt][mt * 2 + 0] = pack2(s[mt][qt][0], s[mt][qt][1]);
        pw[qt][mt * 2 + 1] = pack2(s[mt][qt][2], s[mt][qt][3]);
      }
      l_run[qt] = l_run[qt] * alpha + psum;
      if (__builtin_amdgcn_ballot_w64(alpha != 1.f) != 0ull) {
#pragma unroll
        for (int et = 0; et < 8; ++et) o[et][qt] *= alpha;
      }
    }
    __builtin_amdgcn_sched_barrier(0);
    bf16x8 vf[8];
#pragma unroll
    for (int et = 0; et < 8; ++et) vf[et] = *(const bf16x8*)(sV + (et * 16 + l15) * 72 + q4 * 8);
    __builtin_amdgcn_sched_barrier(0);

#pragma unroll
    for (int et = 0; et < 8; ++et) {
      const bf16x8 a = vf[et];
#pragma unroll
      for (int qt = 0; qt < NQT; ++qt) {
        const bf16x8 b = mk8(pw[qt][0], pw[qt][1], pw[qt][2], pw[qt][3]);
        o[et][qt] = mfma16(a, b, o[et][qt]);
      }
    }

    __builtin_amdgcn_sched_barrier(0);
    if (nmt > 2) {
#pragma unroll
      for (int et = 0; et < 8; ++et) vf[et] = *(const bf16x8*)(sV + (et * 16 + l15) * 72 + 32 + q4 * 8);
      __builtin_amdgcn_sched_barrier(0);

#pragma unroll
      for (int et = 0; et < 8; ++et) {
        const bf16x8 a = vf[et];
#pragma unroll
        for (int qt = 0; qt < NQT; ++qt) {
          const bf16x8 b = mk8(pw[qt][4], pw[qt][5], pw[qt][6], pw[qt][7]);
          o[et][qt] = mfma16(a, b, o[et][qt]);
        }
      }

    }
  }
  float inv[NQT];
#pragma unroll
  for (int qt = 0; qt < NQT; ++qt) inv[qt] = rcpf_(red16_sum(l_run[qt]));
  float* exch = (float*)smem;
  __syncthreads();
  if (c == 1) {
#pragma unroll
    for (int qt = 0; qt < NQT; ++qt)
#pragma unroll
      for (int et = 0; et < 8; ++et)
#pragma unroll
        for (int j = 0; j < 4; ++j)
          exch[(qh * 128 + et * 16 + q4 * 4 + j) * QW + qt * 16 + l15] = o[et][qt][j] * inv[qt];
  }
  __syncthreads();
  if (c == 0) {
    const float* subw = p.in[20] + ei * 128;
#pragma unroll
    for (int qt = 0; qt < NQT; ++qt) {
      const int tok = tokq0 + qh * QW + qt * 16 + l15;
      float ss = 0.f;
#pragma unroll
      for (int et = 0; et < 8; ++et)
#pragma unroll
        for (int j = 0; j < 4; ++j) {
          const float v = o[et][qt][j] * inv[qt] -
                          lam * exch[(qh * 128 + et * 16 + q4 * 4 + j) * QW + qt * 16 + l15];
          o[et][qt][j] = v;
          ss += v * v;
        }
      ss = red16_sum(ss);
      const float rstd = rsqrtf(ss * (1.f / 128.f) + 1e-6f) * (1.f - lam_init);
#pragma unroll
      for (int et = 0; et < 8; ++et) {
        const int e0 = et * 16 + q4 * 4;
        const u32x2 zz = *(const u32x2*)(Zg + (size_t)tok * 1024 + h * 128 + e0);
        const float4 sw4 = *(const float4*)(subw + e0);
        const float r0 = o[et][qt][0] * rstd * sw4.x * siluf_(bflo(zz[0]));
        const float r1 = o[et][qt][1] * rstd * sw4.y * siluf_(bfhi(zz[0]));
        const float r2 = o[et][qt][2] * rstd * sw4.z * siluf_(bflo(zz[1]));
        const float r3 = o[et][qt][3] * rstd * sw4.w * siluf_(bfhi(zz[1]));
        *(u32x2*)(p.HC + (size_t)tok * PCC + h * 128 + e0) = u32x2{pack2(r0, r1), pack2(r2, r3)};
      }
    }
  }
  __syncthreads();
}

__device__ void attn_prompt_item(int wv, PRM p, char* smem, int ei, int h, int cq, float lam, float lam_init) {
  const int tid = tid_opaque(wv), lane = tid & 63, w = tid >> 6;
  const int c = w & 1, qh = w >> 1, l15 = lane & 15, q4 = lane >> 4;
  const u16* Qg = p.PROJ;
  const u16* Kg = p.PROJ + (size_t)1 * NT * 1024;
  const u16* Vtg = p.PROJ + (size_t)2 * NT * 1024;
  const u16* Zg = p.PROJ + (size_t)3 * NT * 1024;
  const int tokq0 = cq * 64;
  bf16x8 qf[2][2];
#pragma unroll
  for (int qt = 0; qt < 2; ++qt)
#pragma unroll
    for (int ks = 0; ks < 2; ++ks)
      qf[qt][ks] = *(const bf16x8*)(Qg + (size_t)(tokq0 + qh * 32 + qt * 16 + l15) * 1024 + h * 128 + c * 64 +
                                    ks * 32 + q4 * 8);
  f32x4 o[8][2];
  float m_run[2], l_run[2];
#pragma unroll
  for (int qt = 0; qt < 2; ++qt) {
    m_run[qt] = -1e30f; l_run[qt] = 0.f;
#pragma unroll
    for (int et = 0; et < 8; ++et) o[et][qt] = f32x4{0.f, 0.f, 0.f, 0.f};
  }
  const int nkt = cq + 1;
  const float SC = 0.125f * 1.4426950408889634f;
  const u16* Ksrc = Kg + (size_t)(w * 16 + (lane >> 4)) * 1024 + h * 128;
  const u16* Vsrc = Vtg + (size_t)(h * 128 + w * 32 + (lane >> 3)) * NT;
  const int vsw0 = ((lane & 7) ^ ((lane >> 4) & 7)) * 8, vsw1 = ((lane & 7) ^ ((4 + (lane >> 4)) & 7)) * 8;
#define A_DMA(KT, ST)                                                                                   \
  _Pragma("unroll") for (int i = 0; i < 4; ++i) {                                                       \
    const int ksw = ((lane & 15) ^ (i * 4 + (lane >> 4))) * 8;                                          \
    __builtin_amdgcn_global_load_lds((const unsigned*)(Ksrc + (size_t)((KT) * 64 + i * 4) * 1024 + ksw), \
        (LAS unsigned*)(smem + (ST) * 32768 + (w * 4 + i) * 1024 + lane * 16), 16, 0, 0);               \
    __builtin_amdgcn_global_load_lds((const unsigned*)(Vsrc + (size_t)(i * 8) * NT + (KT) * 64 + ((i & 1) ? vsw1 : vsw0)), \
        (LAS unsigned*)(smem + (ST) * 32768 + 16384 + (w * 4 + i) * 1024 + lane * 16), 16, 0, 0);       \
  }
  A_DMA(0, 0)
  const unsigned ldsb = (unsigned)(size_t)(LAS const char*)smem;
  const unsigned aK0 = ldsb + l15 * 256 + (((c * 8 + 0 * 4 + q4) ^ l15) * 16);
  const unsigned aK1 = ldsb + l15 * 256 + (((c * 8 + 1 * 4 + q4) ^ l15) * 16);
  const unsigned aV0 = ldsb + 16384 + l15 * 128 + (((0 * 4 + q4) ^ (l15 >> 1)) * 16);
  const unsigned aV1 = ldsb + 16384 + l15 * 128 + (((1 * 4 + q4) ^ (l15 >> 1)) * 16);
  for (int kt = 0; kt < nkt; ++kt) {
    const unsigned so = (kt & 1) * 32768;
    asm volatile("s_waitcnt vmcnt(0)" ::: "memory");
    __builtin_amdgcn_s_barrier();
    if (kt + 1 < nkt) { A_DMA(kt + 1, (kt + 1) & 1) }
    bf16x8 kf[4][2];
#pragma unroll
    for (int mt = 0; mt < 4; ++mt) {
      asm volatile("ds_read_b128 %0, %1 offset:%2" : "=v"(kf[mt][0]) : "v"(aK0 + so), "i"(mt * 4096));
      asm volatile("ds_read_b128 %0, %1 offset:%2" : "=v"(kf[mt][1]) : "v"(aK1 + so), "i"(mt * 4096));
    }
    asm volatile("s_waitcnt lgkmcnt(0)" : "+v"(kf[0][0]), "+v"(kf[0][1]), "+v"(kf[1][0]), "+v"(kf[1][1]), "+v"(kf[2][0]),
                 "+v"(kf[2][1]), "+v"(kf[3][0]), "+v"(kf[3][1]));
    f32x4 s[4][2];

#pragma unroll
    for (int mt = 0; mt < 4; ++mt)
#pragma unroll
      for (int qt = 0; qt < 2; ++qt) {
        s[mt][qt] = f32x4{0.f, 0.f, 0.f, 0.f};
#pragma unroll
        for (int ks = 0; ks < 2; ++ks) s[mt][qt] = mfma16(kf[mt][ks], qf[qt][ks], s[mt][qt]);
      }

    __builtin_amdgcn_sched_barrier(0);
    bf16x8 vf[8];
#pragma unroll
    for (int et = 0; et < 8; ++et)
      asm volatile("ds_read_b128 %0, %1 offset:%2" : "=v"(vf[et]) : "v"(aV0 + so), "i"(et * 2048));
    u32 pw[2][8];
#pragma unroll
    for (int qt = 0; qt < 2; ++qt) {
      float mx = -1e30f;
#pragma unroll
      for (int mt = 0; mt < 4; ++mt)
#pragma unroll
        for (int j = 0; j < 4; ++j) mx = fmaxf(mx, s[mt][qt][j]);
      mx = red16_max(mx) * SC;
      const float mnew = fmaxf(m_run[qt], mx);
      const float alpha = __builtin_amdgcn_exp2f(m_run[qt] - mnew);
      m_run[qt] = mnew;
      float psum = 0.f;
#pragma unroll
      for (int mt = 0; mt < 4; ++mt) {
#pragma unroll
        for (int j = 0; j < 4; ++j) {
          const float pv = __builtin_amdgcn_exp2f(s[mt][qt][j] * SC - mnew);
          psum += pv;
          s[mt][qt][j] = pv;
        }
        pw[qt][mt * 2 + 0] = pack2(s[mt][qt][0], s[mt][qt][1]);
        pw[qt][mt * 2 + 1] = pack2(s[mt][qt][2], s[mt][qt][3]);
      }
      l_run[qt] = l_run[qt] * alpha + psum;
      if (__builtin_amdgcn_ballot_w64(alpha != 1.f) != 0ull) {
#pragma unroll
        for (int et = 0; et < 8; ++et) o[et][qt] *= alpha;
      }
    }
    __builtin_amdgcn_sched_barrier(0);
#pragma unroll
    for (int ks2 = 0; ks2 < 2; ++ks2) {
      if (ks2 == 1) {
#pragma unroll
        for (int et = 0; et < 8; ++et)
          asm volatile("ds_read_b128 %0, %1 offset:%2" : "=v"(vf[et]) : "v"(aV1 + so), "i"(et * 2048));
      }
      asm volatile("s_waitcnt lgkmcnt(0)" : "+v"(vf[0]), "+v"(vf[1]), "+v"(vf[2]), "+v"(vf[3]), "+v"(vf[4]), "+v"(vf[5]),
                   "+v"(vf[6]), "+v"(vf[7]));

#pragma unroll
      for (int et = 0; et < 8; ++et)
#pragma unroll
        for (int qt = 0; qt < 2; ++qt) {
          const bf16x8 b = mk8(pw[qt][ks2 * 4 + 0], pw[qt][ks2 * 4 + 1], pw[qt][ks2 * 4 + 2], pw[qt][ks2 * 4 + 3]);
          o[et][qt] = mfma16(vf[et], b, o[et][qt]);
        }

      __builtin_amdgcn_sched_barrier(0);
    }
  }
#undef A_DMA
  float inv[2];
#pragma unroll
  for (int qt = 0; qt < 2; ++qt) inv[qt] = rcpf_(red16_sum(l_run[qt]));
  float* exch = (float*)smem;
  __syncthreads();
  if (c == 1) {
#pragma unroll
    for (int qt = 0; qt < 2; ++qt)
#pragma unroll
      for (int et = 0; et < 8; ++et)
#pragma unroll
        for (int j = 0; j < 4; ++j)
          exch[(qh * 128 + et * 16 + q4 * 4 + j) * 32 + qt * 16 + l15] = o[et][qt][j] * inv[qt];
  }
  __syncthreads();
  if (c == 0) {
    const float* subw = p.in[20] + ei * 128;
#pragma unroll
    for (int qt = 0; qt < 2; ++qt) {
      const int tok = tokq0 + qh * 32 + qt * 16 + l15;
      float ss = 0.f;
#pragma unroll
      for (int et = 0; et < 8; ++et)
#pragma unroll
        for (int j = 0; j < 4; ++j) {
          const float v = o[et][qt][j] * inv[qt] - lam * exch[(qh * 128 + et * 16 + q4 * 4 + j) * 32 + qt * 16 + l15];
          o[et][qt][j] = v;
          ss += v * v;
        }
      ss = red16_sum(ss);
      const float rstd = rsqrtf(ss * (1.f / 128.f) + 1e-6f) * (1.f - lam_init);
#pragma unroll
      for (int et = 0; et < 8; ++et) {
        const int e0 = et * 16 + q4 * 4;
        const u32x2 zz = *(const u32x2*)(Zg + (size_t)tok * 1024 + h * 128 + e0);
        const float4 sw4 = *(const float4*)(subw + e0);
        const float r0 = o[et][qt][0] * rstd * sw4.x * siluf_(bflo(zz[0]));
        const float r1 = o[et][qt][1] * rstd * sw4.y * siluf_(bfhi(zz[0]));
        const float r2 = o[et][qt][2] * rstd * sw4.z * siluf_(bflo(zz[1]));
        const float r3 = o[et][qt][3] * rstd * sw4.w * siluf_(bfhi(zz[1]));
        *(u32x2*)(p.HC + (size_t)tok * PCC + h * 128 + e0) = u32x2{pack2(r0, r1), pack2(r2, r3)};
      }
    }
  }
  __syncthreads();
}

template <int L>
__device__ __forceinline__ void mlstm_gates(PRM p, int ei, int h, int tok0, int lane, float& ig, float& b) {
  const float* bg = p.in[15] + ei * 16;
  ig = -1e30f;
  float lf = 0.f;
  if (lane < L) {
    const float* g = p.GATES + (size_t)(tok0 + lane) * 16;
    ig = g[h] + bg[h];
    const float f = g[8 + h] + bg[8 + h];
    lf = fminf(f, 0.f) - log1pf(__expf(-fabsf(f)));
  }
  b = lf;
#pragma unroll
  for (int d = 1; d < 64; d <<= 1) {
    const float t = __shfl_up(b, d);
    if (lane >= d) b += t;
  }
}

template <int L>
__device__ void m1_item(int wv, PRM p, char* smem, int ei, int slot, int h, int tok0) {
  const int tid = tid_opaque(wv), lane = tid & 63, w = tid >> 6, l15 = lane & 15, q4 = lane >> 4;
  u16* sKt = (u16*)smem;
  u16* sVt = sKt + 128 * 72;
  float* sws = (float*)(sVt + 128 * 72);
  if (w == 0) {
    float ig, b;
    mlstm_gates<L>(p, ei, h, tok0, lane, ig, b);
    const float blast = __shfl(b, L - 1);
    const float val = (lane < L) ? (blast - b + ig) : -1e30f;
    const float A = wave_max(val);
    if (lane < L) sws[lane] = __expf(val - A);
    if (lane == 0) { p.AB[(slot * 8 + h) * 2] = A; p.AB[(slot * 8 + h) * 2 + 1] = blast; }
  }
  __syncthreads();
  const u16* Kg = p.PROJ + (size_t)5 * NT * 1024;
  const u16* Vg = p.PROJ + (size_t)6 * NT * 1024;
#pragma unroll
  for (int i = 0; i < L * 16 / 256; ++i) {
    const int id = tid + i * 256;
    const int s = id % L, cc = id / L;
    const u32x4 raw = *(const u32x4*)(Kg + (size_t)(tok0 + s) * 1024 + h * 128 + cc * 8);
    const float ws = sws[s];
    const int sp = (s >> 5) * 32 + ((s >> 2) & 3) * 8 + ((s >> 4) & 1) * 4 + (s & 3);
#pragma unroll
    for (int q = 0; q < 4; ++q) {
      sKt[(cc * 8 + 2 * q) * 72 + sp] = f2bf(bflo(raw[q]) * ws);
      sKt[(cc * 8 + 2 * q + 1) * 72 + sp] = f2bf(bfhi(raw[q]) * ws);
    }
  }
  constexpr int CH = L / 8;
#pragma unroll
  for (int i = 0; i < 128 * CH / 256; ++i) {
    const int id = tid + i * 256;
    const int row = id / CH, cc = id % CH;
    *(u32x4*)(sVt + row * 72 + cc * 8) = *(const u32x4*)(Vg + (size_t)(h * 128 + row) * NT + tok0 + cc * 8);
  }
  __syncthreads();
  f32x4 acc[2][8];
#pragma unroll
  for (int mi = 0; mi < 2; ++mi)
#pragma unroll
    for (int nt = 0; nt < 8; ++nt) acc[mi][nt] = f32x4{0.f, 0.f, 0.f, 0.f};
#pragma unroll
  for (int ks = 0; ks < L / 32; ++ks) {
    bf16x8 a[2];
#pragma unroll
    for (int mi = 0; mi < 2; ++mi) a[mi] = *(const bf16x8*)(sKt + ((w * 2 + mi) * 16 + l15) * 72 + ks * 32 + q4 * 8);
#pragma unroll
    for (int nt = 0; nt < 8; ++nt) {
      const bf16x8 b = *(const bf16x8*)(sVt + (nt * 16 + l15) * 72 + ks * 32 + q4 * 8);
#pragma unroll
      for (int mi = 0; mi < 2; ++mi) acc[mi][nt] = mfma16(a[mi], b, acc[mi][nt]);
    }
  }
  u16* U = p.UST + (size_t)(slot * 8 + h) * 16384;
#pragma unroll
  for (int mi = 0; mi < 2; ++mi)
#pragma unroll
    for (int nt = 0; nt < 8; ++nt) {
      const int d0 = (w * 2 + mi) * 16 + q4 * 4, e = nt * 16 + l15;
      *(u32x2*)(U + e * 128 + d0) = u32x2{pack2(acc[mi][nt][0], acc[mi][nt][1]), pack2(acc[mi][nt][2], acc[mi][nt][3])};
    }
  if (tid < 128) {
    float sum = 0.f;
    for (int s = 0; s < L; ++s) sum += bf2f(sKt[tid * 72 + s]);
    p.NST[(size_t)(slot * 8 + h) * 128 + tid] = sum;
  }
  __syncthreads();
}

__device__ void m2_phase(int wv, PRM p, int ei) {
  for (int it = blockIdx.x; it < 388; it += gridDim.x) {
    const int tid = tid_opaque(wv);
    if (it < 256) {
      const int h = it >> 5;
      const int e = (it & 31) * 4 + (tid >> 6), dp = tid & 63;
      u16* ptr = p.UST + (size_t)h * 16384 + e * 128 + dp * 2;
      const size_t CS = (size_t)8 * 16384;
      const bool wm = ((it & 31) == 0) && tid == 0;
      float m = 0.f, C0 = 0.f, C1 = 0.f;
      for (int c0 = 0; c0 < 256; c0 += 32) {
        u32 u[32]; float A[32], B[32];
#pragma unroll
        for (int k = 0; k < 32; ++k) {
          u[k] = *(const u32*)(ptr + (size_t)(c0 + k) * CS);
          A[k] = p.AB[((c0 + k) * 8 + h) * 2];
          B[k] = p.AB[((c0 + k) * 8 + h) * 2 + 1];
        }
#pragma unroll
        for (int k = 0; k < 32; ++k) {
          const float mnew = fmaxf(B[k] + m, A[k]);
          const float dec = __expf(B[k] + m - mnew), sc = __expf(A[k] - mnew);
          *(u32*)(ptr + (size_t)(c0 + k) * CS) = pack2(C0, C1);
          if (wm) p.MST[(c0 + k) * 8 + h] = m;
          C0 = dec * C0 + sc * bflo(u[k]);
          C1 = dec * C1 + sc * bfhi(u[k]);
          m = mnew;
        }
      }
      p.mcp[((size_t)(ei * 8 + h) * 128 + 2 * dp) * 128 + e] = C0;
      p.mcp[((size_t)(ei * 8 + h) * 128 + 2 * dp + 1) * 128 + e] = C1;
      if (wm) p.mmp[ei * 8 + h] = m;
    } else if (it < 260) {
      const int idx = (it - 256) * 256 + tid;
      const int h = idx >> 7, d = idx & 127;
      float m = 0.f, n = 0.f;
      for (int c0 = 0; c0 < 256; c0 += 16) {
        float nv[16], A[16], B[16];
#pragma unroll
        for (int k = 0; k < 16; ++k) {
          nv[k] = p.NST[(size_t)((c0 + k) * 8 + h) * 128 + d];
          A[k] = p.AB[((c0 + k) * 8 + h) * 2];
          B[k] = p.AB[((c0 + k) * 8 + h) * 2 + 1];
        }
#pragma unroll
        for (int k = 0; k < 16; ++k) {
          const float mnew = fmaxf(B[k] + m, A[k]);
          const float dec = __expf(B[k] + m - mnew), sc = __expf(A[k] - mnew);
          p.NST[(size_t)((c0 + k) * 8 + h) * 128 + d] = n;
          n = dec * n + sc * nv[k];
          m = mnew;
        }
      }
      p.mnp[(ei * 8 + h) * 128 + d] = n;
    } else {
      const int bh = it - 260;
      const int b = bh >> 3, h = bh & 7;
      const int slot = 256 + b;
      const float A = p.AB[(slot * 8 + h) * 2], B = p.AB[(slot * 8 + h) * 2 + 1];
      const float m0 = p.in[8][(ei * 16 + b) * 8 + h];
      const float mnew = fmaxf(B + m0, A);
      const float dec = __expf(B + m0 - mnew), sc = __expf(A - mnew);
      u16* U = p.UST + (size_t)(slot * 8 + h) * 16384;
      const float* c0p = p.in[6] + (size_t)((ei * 16 + b) * 8 + h) * 16384;
      float* co = p.mcs + (size_t)((ei * 16 + b) * 8 + h) * 16384;
      for (int k0 = 0; k0 < 32; k0 += 8) {
        u32 uu[8]; float ca[8], cb[8];
#pragma unroll
        for (int k = 0; k < 8; ++k) {
          const int idx = tid + (k0 + k) * 256;
          const int e = idx >> 6, dp = idx & 63;
          uu[k] = *(const u32*)(U + e * 128 + dp * 2);
          ca[k] = c0p[(2 * dp) * 128 + e];
          cb[k] = c0p[(2 * dp + 1) * 128 + e];
        }
#pragma unroll
        for (int k = 0; k < 8; ++k) {
          const int idx = tid + (k0 + k) * 256;
          const int e = idx >> 6, dp = idx & 63;
          co[(2 * dp) * 128 + e] = dec * ca[k] + sc * bflo(uu[k]);
          co[(2 * dp + 1) * 128 + e] = dec * cb[k] + sc * bfhi(uu[k]);
          *(u32*)(U + e * 128 + dp * 2) = pack2(ca[k], cb[k]);
        }
      }
      if (tid < 128) {
        float* np_ = p.NST + (size_t)(slot * 8 + h) * 128 + tid;
        const float nv = *np_;
        const float n0 = p.in[7][((ei * 16 + b) * 8 + h) * 128 + tid];
        p.mns[((ei * 16 + b) * 8 + h) * 128 + tid] = dec * n0 + sc * nv;
        *np_ = n0;
      }
      if (tid == 0) { p.MST[slot * 8 + h] = m0; p.mms[(ei * 16 + b) * 8 + h] = mnew; }
    }
  }
}

template <int L>
__device__ void m3_item(int wv, PRM p, char* smem, int ei, int slot, int h, int tok0) {
  const int tid = tid_opaque(wv), lane = tid & 63, w = tid >> 6, l15 = lane & 15, q4 = lane >> 4;
  u16* sK = (u16*)smem;
  u16* sV = sK + 64 * 136;
  float* fl = (float*)(sV + 128 * 72);
  float* sgs = fl; float* sM = fl + 64; float* sbt = fl + 128; float* sqn = fl + 192; float* sn0 = fl + 256;
  const u16* Qg = p.PROJ + (size_t)4 * NT * 1024;
  const u16* Kg = p.PROJ + (size_t)5 * NT * 1024;
  const u16* Vg = p.PROJ + (size_t)6 * NT * 1024;
  const u16* Og = p.PROJ + (size_t)7 * NT * 1024;
  const u16* Zg = p.PROJ + (size_t)8 * NT * 1024;
  const float m0 = p.MST[slot * 8 + h];
  if (w == 0) {
    float ig, b;
    mlstm_gates<L>(p, ei, h, tok0, lane, ig, b);
    const float gsv = (lane < L) ? (ig - b) : -1e30f;
    float gm = gsv;
#pragma unroll
    for (int d = 1; d < 64; d <<= 1) {
      const float t = __shfl_up(gm, d);
      if (lane >= d) gm = fmaxf(gm, t);
    }
    if (lane < L) { sgs[lane] = gsv; sM[lane] = fmaxf(m0, gm); sbt[lane] = b; }
  }
  if (tid >= 64 && tid < 192) sn0[tid - 64] = p.NST[(size_t)(slot * 8 + h) * 128 + tid - 64];
#pragma unroll
  for (int i = 0; i < L / 16; ++i) {
    const int id = tid + i * 256;
    *(u32x4*)(sK + (id >> 4) * 136 + (id & 15) * 8) =
        *(const u32x4*)(Kg + (size_t)(tok0 + (id >> 4)) * 1024 + h * 128 + (id & 15) * 8);
  }
  constexpr int CH = L / 8;
#pragma unroll
  for (int i = 0; i < 128 * CH / 256; ++i) {
    const int id = tid + i * 256;
    const int row = id / CH, cc = id % CH;
    *(u32x4*)(sV + row * 72 + cc * 8) = *(const u32x4*)(Vg + (size_t)(h * 128 + row) * NT + tok0 + cc * 8);
  }
  __syncthreads();
  if (tid < L) {
    const u16* q = Qg + (size_t)(tok0 + tid) * 1024 + h * 128;
    float a = 0.f;
#pragma unroll
    for (int cc = 0; cc < 16; ++cc) {
      const u32x4 raw = *(const u32x4*)(q + cc * 8);
#pragma unroll
      for (int k = 0; k < 4; ++k) a += bflo(raw[k]) * sn0[cc * 8 + 2 * k] + bfhi(raw[k]) * sn0[cc * 8 + 2 * k + 1];
    }
    sqn[tid] = a;
  }
  __syncthreads();
  if (w * 16 < L) {
    const int t = w * 16 + l15, tok = tok0 + t;
    bf16x8 qf[4];
#pragma unroll
    for (int ks = 0; ks < 4; ++ks) qf[ks] = *(const bf16x8*)(Qg + (size_t)tok * 1024 + h * 128 + ks * 32 + q4 * 8);
    const float Mt = sM[t];
    const float inter = __expf(m0 - Mt);
    const float bt = sbt[t];
    f32x4 sw[4];
    float den = 0.f;
#pragma unroll
    for (int mt = 0; mt < 4; ++mt) {
      sw[mt] = f32x4{0.f, 0.f, 0.f, 0.f};
      if (mt < L / 16 && mt <= w) {
        f32x4 a4 = f32x4{0.f, 0.f, 0.f, 0.f};
#pragma unroll
        for (int ks = 0; ks < 4; ++ks) {
          const bf16x8 a = *(const bf16x8*)(sK + (mt * 16 + l15) * 136 + ks * 32 + q4 * 8);
          a4 = mfma16(a, qf[ks], a4);
        }
#pragma unroll
        for (int j = 0; j < 4; ++j) {
          const int s = mt * 16 + q4 * 4 + j;
          const float wgt = (s <= t) ? __expf(sgs[s] - Mt) : 0.f;
          sw[mt][j] = a4[j] * wgt;
          den += sw[mt][j];
        }
      }
    }
    den = red16_sum(den) + inter * sqn[t];
    const u16* U = p.UST + (size_t)(slot * 8 + h) * 16384;
    f32x4 acc[8];
#pragma unroll
    for (int eh = 0; eh < 2; ++eh) {
      bf16x8 cf[4][4];
#pragma unroll
      for (int e4 = 0; e4 < 4; ++e4)
#pragma unroll
        for (int ks = 0; ks < 4; ++ks)
          cf[e4][ks] = *(const bf16x8*)(U + ((eh * 4 + e4) * 16 + l15) * 128 + ks * 32 + q4 * 8);
      __builtin_amdgcn_sched_barrier(0);
#pragma unroll
      for (int e4 = 0; e4 < 4; ++e4) {
        const int et = eh * 4 + e4;
        acc[et] = f32x4{0.f, 0.f, 0.f, 0.f};
#pragma unroll
        for (int ks = 0; ks < 4; ++ks) acc[et] = mfma16(cf[e4][ks], qf[ks], acc[et]);
        acc[et] *= inter;
      }
      __builtin_amdgcn_sched_barrier(0);
    }
#pragma unroll
    for (int ks2 = 0; ks2 < L / 32; ++ks2) {
      const bf16x8 b = mk8(pack2(sw[2 * ks2][0], sw[2 * ks2][1]), pack2(sw[2 * ks2][2], sw[2 * ks2][3]),
                           pack2(sw[2 * ks2 + 1][0], sw[2 * ks2 + 1][1]), pack2(sw[2 * ks2 + 1][2], sw[2 * ks2 + 1][3]));
#pragma unroll
      for (int et = 0; et < 8; ++et) {
        const bf16x8 a = *(const bf16x8*)(sV + (et * 16 + l15) * 72 + ks2 * 32 + q4 * 8);
        acc[et] = mfma16(a, b, acc[et]);
      }
    }
    const float denom = fmaxf(fabsf(den), __expf(-(bt + Mt)));
    const float invd = rcpf_(denom);
    float ss = 0.f;
#pragma unroll
    for (int et = 0; et < 8; ++et) {
      const int e0 = et * 16 + q4 * 4;
      const u32x2 og = *(const u32x2*)(Og + (size_t)tok * 1024 + h * 128 + e0);
      acc[et][0] *= invd * sigmoidf_(bflo(og[0]));
      acc[et][1] *= invd * sigmoidf_(bfhi(og[0]));
      acc[et][2] *= invd * sigmoidf_(bflo(og[1]));
      acc[et][3] *= invd * sigmoidf_(bfhi(og[1]));
#pragma unroll
      for (int j = 0; j < 4; ++j) ss += acc[et][j] * acc[et][j];
    }
    ss = red16_sum(ss);
    const float rstd = rsqrtf(ss * (1.f / 128.f) + 1e-6f);
    const float* mw = p.in[21] + ei * 1024 + h * 128;
#pragma unroll
    for (int et = 0; et < 8; ++et) {
      const int e0 = et * 16 + q4 * 4;
      const u32x2 zz = *(const u32x2*)(Zg + (size_t)tok * 1024 + h * 128 + e0);
      const float4 w4 = *(const float4*)(mw + e0);
      const float r0 = acc[et][0] * rstd * w4.x * siluf_(bflo(zz[0]));
      const float r1 = acc[et][1] * rstd * w4.y * siluf_(bfhi(zz[0]));
      const float r2 = acc[et][2] * rstd * w4.z * siluf_(bflo(zz[1]));
      const float r3 = acc[et][3] * rstd * w4.w * siluf_(bfhi(zz[1]));
      *(u32x2*)(p.HC + (size_t)tok * PCC + 1024 + h * 128 + e0) = u32x2{pack2(r0, r1), pack2(r2, r3)};
    }
  }
  __syncthreads();
}

template <int L, bool FINAL, bool SAMPLE>
__device__ void rg_item(int wv, PRM p, char* smem, int o, int hc, int tokc0, int nsub, int seqstart, int chunk, int b) {
  const int tid = tid_opaque(wv), lane = tid & 63, w = tid >> 6, l15 = lane & 15, q4 = lane >> 4;
  u16* sX = (u16*)smem;
  u16* sA = sX + 67 * 136;
  u16* sZ = sA + 64 * 136;
  u16* sO = sZ + 64 * 136;
  const u16* XZ = p.PROJ;
  float ba[2], bx[2], cl[2], carryH[2], carryP[2];
  bf16x8 waf[2][4], wxf[2][4];
#pragma unroll
  for (int nt = 0; nt < 2; ++nt) {
    const int chl = w * 32 + nt * 16 + l15;
    const int chg = hc * 128 + chl;
    ba[nt] = p.in[27][o * 2048 + chg];
    bx[nt] = p.in[29][o * 2048 + chg];
    const float lm = p.in[30][o * 2048 + chg];
    const float sp = fmaxf(-lm, 0.f) + log1pf(__expf(-fabsf(lm)));
    cl[nt] = -8.f * sp;
#pragma unroll
    for (int ks = 0; ks < 4; ++ks) {
      waf[nt][ks] = *(const bf16x8*)(p.Wra[o] + (size_t)(hc * 128 + chl) * 128 + ks * 32 + q4 * 8);
      wxf[nt][ks] = *(const bf16x8*)(p.Wrx[o] + (size_t)(hc * 128 + chl) * 128 + ks * 32 + q4 * 8);
    }
    carryP[nt] = 1.f;
    if (SAMPLE) {
      carryH[nt] = p.in[10][(o * 16 + b) * 2048 + chg];
    } else {
      float hh = 0.f;
      if (FINAL) {
        for (int c2 = 0; c2 < chunk; c2 += 16) {
          float2 ag[16];
#pragma unroll
          for (int k = 0; k < 16; ++k) {
            ag[k] = make_float2(1.f, 0.f);
            if (c2 + k < chunk) ag[k] = *(const float2*)(p.AGG + ((size_t)(c2 + k) * 2048 + chg) * 2);
          }
#pragma unroll
          for (int k = 0; k < 16; ++k) hh = ag[k].x * hh + ag[k].y;
        }
      }
      carryH[nt] = hh;
    }
  }
  const int cg_ = tid & 15;
  float* sCW = (float*)(sO + 64 * 136);
  __syncthreads();
  for (int i = tid; i < 5 * 128; i += NTHR) {
    const int j = i >> 7, ch = i & 127;
    sCW[i] = (j < 4) ? p.in[24][(size_t)o * 4 * 2048 + j * 2048 + hc * 128 + ch] : p.in[25][(size_t)o * 2048 + hc * 128 + ch];
  }
  constexpr int NXI = ((L + 3) * 16 + 255) / 256;
  constexpr int NZI = L * 16 / 256;
  u32x4 rx[NXI], rz[NZI];
#define RG_LOAD(T0)                                                                                \
  {                                                                                                \
    _Pragma("unroll") for (int i = 0; i < NXI; ++i) {                                              \
      const int id = tid + i * 256;                                                                \
      const int r = id >> 4, cc = id & 15;                                                         \
      const int tk = (T0) - 3 + r;                                                                 \
      u32x4 v = u32x4{0u, 0u, 0u, 0u};                                                             \
      if (id < (L + 3) * 16) {                                                                     \
        if (tk >= seqstart) {                                                                      \
          v = *(const u32x4*)(XZ + (size_t)tk * 4096 + hc * 128 + cc * 8);                         \
        } else if (SAMPLE) {                                                                       \
          const float* bf = p.in[9] + ((size_t)(o * 16 + b) * 3 + r) * 2048 + hc * 128 + cc * 8;   \
          const float4 f0 = *(const float4*)bf, f1 = *(const float4*)(bf + 4);                     \
          v = u32x4{pack2(f0.x, f0.y), pack2(f0.z, f0.w), pack2(f1.x, f1.y), pack2(f1.z, f1.w)};   \
        }                                                                                          \
      }                                                                                            \
      rx[i] = v;                                                                                   \
    }                                                                                              \
    if (FINAL) {                                                                                   \
      _Pragma("unroll") for (int i = 0; i < NZI; ++i) {                                            \
        const int id = tid + i * 256;                                                              \
        rz[i] = *(const u32x4*)(XZ + (size_t)((T0) + (id >> 4)) * 4096 + 2048 + hc * 128 + (id & 15) * 8); \
      }                                                                                            \
    }                                                                                              \
  }
  RG_LOAD(tokc0)
  for (int st = 0; st < nsub; ++st) {
    const int t0 = tokc0 + st * L;
    __syncthreads();
#pragma unroll
    for (int i = 0; i < NXI; ++i) {
      const int id = tid + i * 256;
      if (id < (L + 3) * 16) *(u32x4*)(sX + (id >> 4) * 136 + (id & 15) * 8) = rx[i];
    }
    if (FINAL) {
#pragma unroll
      for (int i = 0; i < NZI; ++i) {
        const int id = tid + i * 256;
        *(u32x4*)(sZ + (id >> 4) * 136 + (id & 15) * 8) = rz[i];
      }
    }
    __syncthreads();
    {
      float cw[4][8], cb[8];
#pragma unroll
      for (int k = 0; k < 8; ++k) {
        cb[k] = sCW[4 * 128 + cg_ * 8 + k];
#pragma unroll
        for (int j = 0; j < 4; ++j) cw[j][k] = sCW[j * 128 + cg_ * 8 + k];
      }
#pragma unroll
      for (int i = 0; i < L * 16 / 256; ++i) {
        const int id = tid + i * 256;
        const int t = id >> 4;
        float xc[8];
#pragma unroll
        for (int k = 0; k < 8; ++k) xc[k] = cb[k];
#pragma unroll
        for (int j = 0; j < 4; ++j) {
          const u32x4 xv = *(const u32x4*)(sX + (t + j) * 136 + cg_ * 8);
#pragma unroll
          for (int q = 0; q < 4; ++q) {
            xc[2 * q] += cw[j][2 * q] * bflo(xv[q]);
            xc[2 * q + 1] += cw[j][2 * q + 1] * bfhi(xv[q]);
          }
        }
        *(u32x4*)(sA + t * 136 + cg_ * 8) =
            u32x4{pack2(xc[0], xc[1]), pack2(xc[2], xc[3]), pack2(xc[4], xc[5]), pack2(xc[6], xc[7])};
      }
    }
    __syncthreads();
    if (st + 1 < nsub) { RG_LOAD(t0 + L) }
    __builtin_amdgcn_sched_barrier(0);
#pragma unroll
    for (int nt = 0; nt < 2; ++nt) {
      constexpr int MTN = L / 16;
      const int chl = w * 32 + nt * 16 + l15;
      float hl[MTN][4], pl[MTN][4], Pt[MTN], Ht[MTN];
#pragma unroll
      for (int mt = 0; mt < MTN; ++mt) {
        f32x4 ar = f32x4{0.f, 0.f, 0.f, 0.f}, ai = f32x4{0.f, 0.f, 0.f, 0.f};
#pragma unroll
        for (int ks = 0; ks < 4; ++ks) {
          const bf16x8 a = *(const bf16x8*)(sA + (mt * 16 + l15) * 136 + ks * 32 + q4 * 8);
          ar = mfma16(a, waf[nt][ks], ar);
          ai = mfma16(a, wxf[nt][ks], ai);
        }
        float P = 1.f, H = 0.f;
#pragma unroll
        for (int j = 0; j < 4; ++j) {
          const int t = mt * 16 + q4 * 4 + j;
          const float xc = bf2f(sA[t * 136 + chl]);
          const float rr = sigmoidf_(ar[j] + ba[nt]);
          const float ii = sigmoidf_(ai[j] + bx[nt]);
          const float la = cl[nt] * rr;
          const float a = __expf(la);
          const float x2 = 2.f * la;
          const float om = (x2 > -0.02f) ? (-x2 * (1.f + x2 * (0.5f + x2 * (1.f / 6.f)))) : (1.f - a * a);
          const float u = __builtin_amdgcn_sqrtf(om) * ii * xc;
          H = a * H + u;
          P = a * P;
          hl[mt][j] = H; pl[mt][j] = P;
        }
        Pt[mt] = P; Ht[mt] = H;
      }
      float Pe[MTN], He[MTN], Pq[MTN], Hq[MTN];
#pragma unroll
      for (int mt = 0; mt < MTN; ++mt) {
        const float Pp = __shfl_up(Pt[mt], 16), Hp = __shfl_up(Ht[mt], 16);
        if (q4 >= 1) { Ht[mt] = Pt[mt] * Hp + Ht[mt]; Pt[mt] = Pt[mt] * Pp; }
      }
#pragma unroll
      for (int mt = 0; mt < MTN; ++mt) {
        const float Pp = __shfl_up(Pt[mt], 32), Hp = __shfl_up(Ht[mt], 32);
        if (q4 >= 2) { Ht[mt] = Pt[mt] * Hp + Ht[mt]; Pt[mt] = Pt[mt] * Pp; }
      }
#pragma unroll
      for (int mt = 0; mt < MTN; ++mt) {
        Pe[mt] = __shfl_up(Pt[mt], 16); He[mt] = __shfl_up(Ht[mt], 16);
        if (q4 == 0) { Pe[mt] = 1.f; He[mt] = 0.f; }
        Pq[mt] = __shfl(Pt[mt], 48 + l15); Hq[mt] = __shfl(Ht[mt], 48 + l15);
      }
#pragma unroll
      for (int mt = 0; mt < MTN; ++mt) {
        const float hb = Pe[mt] * carryH[nt] + He[mt];
        if (FINAL) {
#pragma unroll
          for (int j = 0; j < 4; ++j) {
            const int t = mt * 16 + q4 * 4 + j;
            const float hv = pl[mt][j] * hb + hl[mt][j];
            const float z = bf2f(sZ[t * 136 + chl]);
            sO[t * 136 + chl] = f2bf(hv * siluf_(z));
            if (st == nsub - 1 && mt == MTN - 1 && j == 3 && q4 == 3) {
              if (SAMPLE) p.rgs[(o * 16 + b) * 2048 + hc * 128 + chl] = hv;
              else if (chunk == 63) p.rgp[o * 2048 + hc * 128 + chl] = hv;
            }
          }
        }
        carryH[nt] = Pq[mt] * carryH[nt] + Hq[mt];
        carryP[nt] = carryP[nt] * Pq[mt];
      }
    }
    if (FINAL) {
      __syncthreads();
#pragma unroll
      for (int i = 0; i < L * 16 / 256; ++i) {
        const int id = tid + i * 256;
        *(u32x4*)(p.HC + (size_t)(t0 + (id >> 4)) * PCC + hc * 128 + (id & 15) * 8) =
            *(const u32x4*)(sO + (id >> 4) * 136 + (id & 15) * 8);
      }
      if (st == nsub - 1 && (SAMPLE || chunk == 63)) {
        for (int id = tid; id < 3 * 128; id += NTHR) {
          const int j = id >> 7, ch = id & 127;
          const float v = bf2f(sX[(L + j) * 136 + ch]);
          if (SAMPLE) p.convs[((size_t)(o * 16 + b) * 3 + j) * 2048 + hc * 128 + ch] = v;
          else p.convp[((size_t)o * 3 + j) * 2048 + hc * 128 + ch] = v;
        }
      }
    }
  }
  if (!FINAL) {
    if (q4 == 0) {
#pragma unroll
      for (int nt = 0; nt < 2; ++nt) {
        const int chg = hc * 128 + w * 32 + nt * 16 + l15;
        *(float2*)(p.AGG + ((size_t)chunk * 2048 + chg) * 2) = make_float2(carryP[nt], carryH[nt]);
      }
    }
  }
#undef RG_LOAD
}

#define XB_TMO      128
#define XB_XCNT(j)  (256  + 64 * (j))
#define XB_XSUB(j)  (1280 + 64 * (j))
#define XB_XGEN(j)  (2304 + 64 * (j))
#define XB_TOP      3328
#define XB_TOPGEN   3392
#define XCD_BAR_WORDS 3456
#define XB_SPIN_CAP (1u << 18)
__device__ __forceinline__ unsigned xb_ld(unsigned* p)              { return __hip_atomic_load(p, __ATOMIC_RELAXED, __HIP_MEMORY_SCOPE_AGENT); }
__device__ __forceinline__ unsigned xb_add(unsigned* p, unsigned v) { return __hip_atomic_fetch_add(p, v, __ATOMIC_RELAXED, __HIP_MEMORY_SCOPE_AGENT); }
__device__ __forceinline__ unsigned xb_xcc_id() { return (unsigned)__builtin_amdgcn_s_getreg((3 << 11) | 20) & 0xFu; }
#define XB_SPIN(cond, bar) do { unsigned _sp = 0; while (cond) { __builtin_amdgcn_s_sleep(1); \
    if ((++_sp & 255u) == 0u) { if (xb_ld(&(bar)[XB_TMO])) break; if (_sp > XB_SPIN_CAP) { atomicAdd(&(bar)[XB_TMO], 1u); break; } } } } while (0)
struct XcdBarrier { unsigned* bar; unsigned x; volatile LAS unsigned* st; };
__device__ __forceinline__ XcdBarrier xcd_barrier_post(unsigned* bar, volatile LAS unsigned* st) {
    XcdBarrier b; b.bar = bar; b.x = xb_xcc_id(); b.st = st;
    if (threadIdx.x == 0) (void)xb_add(&bar[XB_XCNT(b.x)], 1u);
    return b;
}
__device__ __forceinline__ void xcd_barrier_complete(unsigned* bar, unsigned x, unsigned& nloc, unsigned& nx) {
    const unsigned G = gridDim.x * gridDim.y * gridDim.z;
    unsigned sum, cnt, mine, sp = 0u;
    for (;;) {
        sum = 0u; cnt = 0u; mine = 0u;
#pragma unroll
        for (unsigned j = 0; j < 16; ++j) { const unsigned c = xb_ld(&bar[XB_XCNT(j)]); sum += c; cnt += (c > 0u) ? 1u : 0u; mine = (j == x) ? c : mine; }
        if (sum == G) break;
        __builtin_amdgcn_s_sleep(1);
        if ((++sp & 255u) == 0u) { if (xb_ld(&bar[XB_TMO])) break; if (sp > XB_SPIN_CAP) { atomicAdd(&bar[XB_TMO], 1u); break; } }
    }
    nloc = mine > 0u ? mine : 1u; nx = cnt > 0u ? cnt : 1u;
}
__device__ __forceinline__ void xcd_barrier(const XcdBarrier& b, bool leader) {
    asm volatile("s_waitcnt vmcnt(0)" ::: "memory");
    __syncthreads();
    if (leader) {
        unsigned* bar = b.bar;
        __builtin_amdgcn_s_waitcnt(0);
        unsigned nloc = b.st[0], nx = b.st[1];
        if (nloc == 0u) { xcd_barrier_complete(bar, b.x, nloc, nx); b.st[0] = nloc; b.st[1] = nx; }
        const unsigned old = xb_add(&bar[XB_XSUB(b.x)], 1u);
        const unsigned gen = old / nloc;
        if (old + 1u == (gen + 1u) * nloc) {
            __builtin_amdgcn_fence(__ATOMIC_RELEASE, "agent");
            asm volatile("s_waitcnt vmcnt(0)" ::: "memory");
            const unsigned og = xb_add(&bar[XB_TOP], 1u);
            const unsigned tg = og / nx;
            if (og + 1u == (tg + 1u) * nx) xb_add(&bar[XB_TOPGEN], 1u);
            else XB_SPIN(xb_ld(&bar[XB_TOPGEN]) == tg, bar);
            __builtin_amdgcn_fence(__ATOMIC_ACQUIRE, "agent");
            xb_add(&bar[XB_XGEN(b.x)], 1u);
            asm volatile("s_waitcnt vmcnt(0)" ::: "memory");
        } else {
            XB_SPIN(xb_ld(&bar[XB_XGEN(b.x)]) == gen, bar);
            __builtin_amdgcn_fence(__ATOMIC_ACQUIRE, "agent");
            asm volatile("s_waitcnt vmcnt(0)" ::: "memory");
        }
    }
    __syncthreads();
}

__device__ __forceinline__ int snake(int r, int G, int b) { return (r & 1) ? (r * G + (G - 1 - b)) : (r * G + b); }
__device__ __forceinline__ PRMP launder(PRMP q) { asm volatile("" : "+s"(q)); return q; }

__device__ void attn_phase(int wv, PRMP pp, char* smem, int li) {
  const int G = gridDim.x, bid = blockIdx.x, ei = li >> 1;
  const float lam_init = 0.8f - 0.6f * expf(-0.3f * (float)li);
  float lam;
  {
    PRM p = *launder(pp);
    const int lane = tid_opaque(wv) & 63;
    const float s1 = wave_sum(p.in[16][ei * 64 + lane] * p.in[17][ei * 64 + lane]);
    const float s2 = wave_sum(p.in[18][ei * 64 + lane] * p.in[19][ei * 64 + lane]);
    lam = expf(s1) - expf(s2) + lam_init;
  }
  const int hx = bid & 7, lb = bid >> 3, nlb = G >> 3;
  for (int rr = 0; rr < ((REPA & 1) ? 2 : 1); ++rr) {
    PRM p = *launder(pp);
    for (int it = lb; it < 16; it += nlb) attn_item<1, true>(wv, p, smem, ei, hx, it, lam, lam_init);
  }
  for (int rr = 0; rr < ((REPA & 2) ? 2 : 1); ++rr) {
    PRM p = *launder(pp);
    for (int r = 0; r * nlb < 256; ++r) {
      const int k = snake(r, nlb, lb);
      if (k < 256) attn_prompt_item(wv, p, smem, ei, hx, 255 - k, lam, lam_init);
    }
  }
  for (int rr = 0; rr < ((REPA & 4) ? 2 : 1); ++rr) {
    PRM p = *launder(pp);
    for (int k = bid; k < 2048; k += G) m1_item<64>(wv, p, smem, ei, k >> 3, k & 7, (k >> 3) * 64);
  }
  if (PM & 64) {
    PRM p = *launder(pp);
    for (int k2 = G - 1 - bid; k2 < 128; k2 += G) m1_item<32>(wv, p, smem, ei, 256 + (k2 >> 3), k2 & 7, SP + (k2 >> 3) * 32);
  }
}

__device__ void run_phase(int wv, PRMP pp, char* smem, int ph) {
  const int G = gridDim.x, bid = blockIdx.x;
  if (ph == 0) { if (PM & 1) prologue_phase(wv, *launder(pp), smem); return; }
  if (ph == 25) { if (PM & 2) norm_phase(wv, *launder(pp), 4); return; }
  const int li = (ph - 1) / 6, sub = (ph - 1) % 6;
  const bool even = (li & 1) == 0;
  const int ei = li >> 1, o = li >> 1;
  if (sub == 0) { if (PM & 2) norm_phase(wv, *launder(pp), li); return; }
  if (sub == 1) {
    if (!(PM & 4)) return;
    PRM p = *launder(pp);
    if (even) gemm_phase<EPI_INEVEN, 256>(wv, p, smem, p.HC, 1024, p.Wie[ei], 1024, 1024, 73, li);
    else gemm_phase<EPI_INODD, 256>(wv, p, smem, p.HC, 1024, p.Wio[o], 1024, 1024, 32, li);
    return;
  }
  if (sub == 5) {
    PRM p = *launder(pp);
    if (PM & 8) gemm_phase<EPI_OUT, 128>(wv, p, smem, p.HC, PCC, even ? p.Woe[ei] : p.Woo[o], PWO, 2048, 8, li);
    return;
  }
  if (even) {
    if (sub == 2) {
      attn_phase(wv, pp, smem, li);
    } else if (sub == 3) {
      if (PM & 128) m2_phase(wv, *launder(pp), ei);
    } else {
      if (PM & 256) {
        { PRM p = *launder(pp);
          for (int it = bid; it < 2048; it += G) m3_item<64>(wv, p, smem, ei, it >> 3, it & 7, (it >> 3) * 64); }
        { PRM p = *launder(pp);
          for (int k2 = G - 1 - bid; k2 < 128; k2 += G) m3_item<32>(wv, p, smem, ei, 256 + (k2 >> 3), k2 & 7, SP + (k2 >> 3) * 32); }
      }
    }
  } else {
    if (sub == 2) {
      PRM p = *launder(pp);
      if (PM & 512) for (int it = bid; it < 63 * 16; it += G)
        rg_item<64, false, false>(wv, p, smem, o, it & 15, (it >> 4) * 256, 4, 0, it >> 4, 0);
    } else if (sub == 3) {
      if (PM & 1024) {
        { PRM p = *launder(pp);
          for (int it = bid; it < 1024; it += G) rg_item<64, true, false>(wv, p, smem, o, it & 15, (it >> 4) * 256, 4, 0, it >> 4, 0); }
        { PRM p = *launder(pp);
          for (int k = G - 1 - bid; k < 256; k += G) rg_item<32, true, true>(wv, p, smem, o, k & 15, SP + (k >> 4) * 32, 1, SP + (k >> 4) * 32, 0, k >> 4); }
      }
    }
  }
}

__device__ __forceinline__ bool phase_is_nop(int ph) {
  if (ph == 0 || ph == 25) return false;
  const int li = (ph - 1) / 6, sub = (ph - 1) % 6;
  return (li & 1) && sub == 4;
}

__global__ void __launch_bounds__(NTHR, 2) fwd_kernel(Params p_unused, int ph_begin, int ph_end) {
  __shared__ __attribute__((aligned(16))) char smem[SMEM_BYTES];
  __shared__ uint4 xb_words;
  PRMP pp = (PRMP)__builtin_amdgcn_kernarg_segment_ptr();
  const int wv = __builtin_amdgcn_readfirstlane((int)(threadIdx.x >> 6));
  if (threadIdx.x == 0) xb_words = make_uint4(0u, 0u, 0u, 0u);
  __syncthreads();
  if (ph_end - ph_begin > 1) (void)xcd_barrier_post(launder(pp)->BAR, (volatile LAS unsigned*)&xb_words);
  int nsync = 0;
  for (int ph2 = ph_begin * 2; ph2 < ph_end * 2; ++ph2) {
    const int ph = ph2 >> 1;
    if (phase_is_nop(ph)) continue;
    if (ph2 & 1) {
      if (!REP) continue;
      const int li = (ph - 1) / 6, sub = (ph - 1) % 6;
      int bit = 0;
      if (ph == 0) bit = 1;
      else if (ph == 25) bit = 0;
      else if (sub == 0) bit = 2;
      else if (sub == 1) bit = 4;
      else if (sub == 2) bit = (li & 1) ? 512 : 0x70;
      else if (sub == 3) bit = (li & 1) ? 1024 : 0;
      else if (sub == 4) bit = 256;
      else if (sub == 5 && li == 0) bit = 0x800;
      if (!(REP & bit)) continue;
    }
    if (ph2 != ph_begin * 2) {
      if (ph_begin < 0) cg::this_grid().sync();
      {
        XcdBarrier xb;
        xb.bar = launder(pp)->BAR; xb.x = xb_xcc_id(); xb.st = (volatile LAS unsigned*)&xb_words;
        xcd_barrier(xb, wv == 0 && __lane_id() == 0);
      }
      ++nsync;
    }
    run_phase(wv, pp, smem, ph);
  }
}

extern "C" void kernel_launch(void* const* d_in, const int* in_sizes, int n_in, void* d_out, int out_size,
                              void* d_ws, size_t ws_size, hipStream_t stream) {
  Params p;
  memset(&p, 0, sizeof(p));
  for (int i = 0; i < 33; ++i) p.in[i] = (const float*)d_in[i];
  float* o = (float*)d_out;
  size_t off = 0;
  p.y = o; off += (size_t)NT * 1024;
  p.kp = o + off; off += (size_t)2 * SP * 1024;
  p.vp = o + off; off += (size_t)2 * SP * 1024;
  p.mcp = o + off; off += (size_t)2 * 8 * 16384;
  p.mnp = o + off; off += 2 * 8 * 128;
  p.mmp = o + off; off += 2 * 8;
  p.convp = o + off; off += 2 * 3 * 2048;
  p.rgp = o + off; off += 2 * 2048;
  p.ks = o + off; off += (size_t)2 * 512 * 1024;
  p.vs = o + off; off += (size_t)2 * 512 * 1024;
  p.mcs = o + off; off += (size_t)2 * 16 * 8 * 16384;
  p.mns = o + off; off += 2 * 16 * 8 * 128;
  p.mms = o + off; off += 2 * 16 * 8;
  p.convs = o + off; off += 2 * 16 * 3 * 2048;
  p.rgs = o + off; off += 2 * 16 * 2048;

  char* ws = (char*)d_ws;
  size_t wo = 0;
  auto take = [&](size_t bytes) { char* r = ws + wo; wo += (bytes + 255) & ~(size_t)255; return r; };
  p.HC = (u16*)take((size_t)NT * PCC * 2);
  p.PROJ = (u16*)take((size_t)NT * 9216 * 2);
  p.UST = (u16*)take((size_t)NSLOT * 8 * 16384 * 2);
  for (int e = 0; e < 2; ++e) p.Wie[e] = (u16*)take((size_t)9344 * 1024 * 2);
  for (int e = 0; e < 2; ++e) p.Woe[e] = (u16*)take((size_t)1024 * PWO * 2);
  for (int e = 0; e < 2; ++e) p.Wio[e] = (u16*)take((size_t)4096 * 1024 * 2);
  for (int e = 0; e < 2; ++e) p.Woo[e] = (u16*)take((size_t)1024 * PWO * 2);
  for (int e = 0; e < 2; ++e) p.Wra[e] = (u16*)take((size_t)16 * 128 * 128 * 2);
  for (int e = 0; e < 2; ++e) p.Wrx[e] = (u16*)take((size_t)16 * 128 * 128 * 2);
  p.MODS = (float*)take((size_t)4 * 17 * 3072 * 4);
  p.GATES = (float*)take((size_t)NT * 16 * 4);
  p.AB = (float*)take((size_t)NSLOT * 8 * 2 * 4);
  p.NST = (float*)take((size_t)NSLOT * 8 * 128 * 4);
  p.MST = (float*)take((size_t)NSLOT * 8 * 4);
  p.AGG = (float*)take((size_t)64 * 2048 * 2 * 4);
  p.BAR = (unsigned*)take((size_t)XCD_BAR_WORDS * 4);
  if (wo > ws_size) { fprintf(stderr, "workspace too small: need %zu have %zu\n", wo, ws_size); return; }

  int ti = 0, tstart = 0;
  auto addt = [&](const float* src, u16* dst, int K, int N, int Npad, int nb, int ldd) {
    TDesc& d = p.td[ti++];
    d.src = src; d.dst = dst; d.K = K; d.N = N; d.Npad = Npad; d.nb = nb; d.tstart = tstart; d.ldd = ldd;
    d.per = (K / 64) * (Npad / 64);
    tstart += d.per * nb;
  };
  for (int e = 0; e < 2; ++e) addt(p.in[14] + (size_t)e * 1024 * 9232, p.Wie[e], 1024, 9232, 9344, 1, 1024);
  for (int e = 0; e < 2; ++e) addt(p.in[22] + (size_t)e * 2048 * 1024, p.Woe[e], 2048, 1024, 1024, 1, PWO);
  for (int e = 0; e < 2; ++e) addt(p.in[23] + (size_t)e * 1024 * 4096, p.Wio[e], 1024, 4096, 4096, 1, 1024);
  for (int e = 0; e < 2; ++e) addt(p.in[31] + (size_t)e * 2048 * 1024, p.Woo[e], 2048, 1024, 1024, 1, PWO);
  for (int e = 0; e < 2; ++e) addt(p.in[26] + (size_t)e * 16 * 16384, p.Wra[e], 128, 128, 128, 16, 128);
  for (int e = 0; e < 2; ++e) addt(p.in[28] + (size_t)e * 16 * 16384, p.Wrx[e], 128, 128, 128, 16, 128);
  p.ntr = tstart;

  static int grid_blocks = 0;
  if (!grid_blocks) {
    int dev = 0, cus = 0, per_cu = 0;
    hipGetDevice(&dev);
    hipDeviceGetAttribute(&cus, hipDeviceAttributeMultiprocessorCount, dev);
    hipOccupancyMaxActiveBlocksPerMultiprocessor(&per_cu, fwd_kernel, NTHR, 0);
    if (per_cu > 2) per_cu = 2;
    if (per_cu < 1) per_cu = 1;
    grid_blocks = cus * per_cu;
  }
#if MEGA
  hipMemsetAsync(p.BAR, 0, (size_t)XCD_BAR_WORDS * 4, stream);
  int b = 0, e = 26;
  void* args[] = {&p, &b, &e};
  hipError_t err = hipLaunchCooperativeKernel((void*)fwd_kernel, dim3(grid_blocks), dim3(NTHR), args, 0, stream);
  if (err != hipSuccess) fprintf(stderr, "cooperative launch failed: %s (grid %d)\n", hipGetErrorString(err), grid_blocks);
#else
  for (int ph = 0; ph < 26; ++ph) {
    bool nop = false;
    if (ph != 0 && ph != 25) { int li = (ph - 1) / 6, sub = (ph - 1) % 6; nop = (li & 1) && sub == 4; }
    if (nop) continue;
    fwd_kernel<<<grid_blocks, NTHR, 0, stream>>>(p, ph, ph + 1);
  }
#endif
}
```

```cpp
#include <hip/hip_runtime.h>
#include <hip/hip_cooperative_groups.h>
#include <cstdio>
#include <cstring>
namespace cg = cooperative_groups;

#ifndef MEGA
#define MEGA 1
#endif
#ifndef PM
#define PM 0xffff
#endif
#ifndef REP
#define REP 0
#endif
#ifndef REPA
#define REPA 0
#endif

#define LAS __attribute__((address_space(3)))
typedef unsigned short u16;
typedef unsigned int u32;
using bf16x8 = __attribute__((ext_vector_type(8))) short;
using f32x4 = __attribute__((ext_vector_type(4))) float;
using u32x4 = __attribute__((ext_vector_type(4))) unsigned int;
using u32x2 = __attribute__((ext_vector_type(2))) unsigned int;

#define NT 16896
#define SP 16384
#define NTHR 256
#define SMEM_BYTES 73728
#define NSLOT 272
#define PCC 2112
#define PWO 2112

struct TDesc { const float* src; u16* dst; int K, N, Npad, nb, tstart, per, ldd, pad; };

struct Params {
  const float* in[33];
  float *y, *kp, *vp, *mcp, *mnp, *mmp, *convp, *rgp, *ks, *vs, *mcs, *mns, *mms, *convs, *rgs;
  u16 *HC, *PROJ, *UST;
  u16 *Wie[2], *Woe[2], *Wio[2], *Woo[2], *Wra[2], *Wrx[2];
  float *MODS, *GATES, *AB, *NST, *MST, *AGG;
  unsigned* BAR;
  TDesc td[12];
  int ntr;
  int pad;
};

typedef const __attribute__((address_space(4))) Params& PRM;
typedef const __attribute__((address_space(4))) Params* PRMP;
__device__ __forceinline__ float bf2f(u16 h) { return __uint_as_float(((u32)h) << 16); }
__device__ __forceinline__ float bflo(u32 w) { return __uint_as_float(w << 16); }
__device__ __forceinline__ float bfhi(u32 w) { return __uint_as_float(w & 0xffff0000u); }
typedef __bf16 bf2_t __attribute__((ext_vector_type(2)));
typedef float f2_t __attribute__((ext_vector_type(2)));
__device__ __forceinline__ u32 pack2(float a, float b) {
  f2_t v = {a, b};
  bf2_t r = __builtin_convertvector(v, bf2_t);
  return __builtin_bit_cast(u32, r);
}
__device__ __forceinline__ u16 f2bf(float a) { return (u16)(pack2(a, 0.f) & 0xffffu); }
__device__ __forceinline__ f32x4 mfma16(bf16x8 a, bf16x8 b, f32x4 c) {
  return __builtin_amdgcn_mfma_f32_16x16x32_bf16(a, b, c, 0, 0, 0);
}
__device__ __forceinline__ bf16x8 mk8(u32 a, u32 b, u32 c, u32 d) {
  u32x4 v = {a, b, c, d};
  return __builtin_bit_cast(bf16x8, v);
}
__device__ __forceinline__ float red16_max(float v) {
  v = fmaxf(v, __shfl_xor(v, 16));
  v = fmaxf(v, __shfl_xor(v, 32));
  return v;
}
__device__ __forceinline__ float red16_sum(float v) {
  v += __shfl_xor(v, 16);
  v += __shfl_xor(v, 32);
  return v;
}
__device__ __forceinline__ float wave_sum(float v) {
#pragma unroll
  for (int d = 1; d < 64; d <<= 1) v += __shfl_xor(v, d);
  return v;
}
__device__ __forceinline__ float wave_max(float v) {
#pragma unroll
  for (int d = 1; d < 64; d <<= 1) v = fmaxf(v, __shfl_xor(v, d));
  return v;
}
__device__ __forceinline__ float rcpf_(float x) { return __builtin_amdgcn_rcpf(x); }
__device__ __forceinline__ float sigmoidf_(float x) { return rcpf_(1.f + __expf(-x)); }
__device__ __forceinline__ float siluf_(float x) { return x * rcpf_(1.f + __expf(-x)); }
__device__ __forceinline__ int tid_opaque(int wv) { int t = wv * 64 + (int)__lane_id(); asm volatile("" : "+v"(t)); return t & 255; }
__device__ __forceinline__ int vpos(int cc) { return (cc >> 2) * 32 + (cc & 1) * 16 + ((cc >> 1) & 1) * 4; }
__device__ __forceinline__ void vstore(u16* row, int cc, u32x4 v) {
  const int pa = vpos(cc);
  *(u32x2*)(row + pa) = u32x2{v[0], v[1]};
  *(u32x2*)(row + pa + 8) = u32x2{v[2], v[3]};
}
__device__ __forceinline__ int seqid(int tok) { return tok < SP ? 0 : 1 + ((tok - SP) >> 5); }

__device__ void transpose_tile(int wv, PRM p, char* smem, int t) {
  int di = 0;
#pragma unroll
  for (int i = 1; i < 12; ++i) if (t >= p.td[i].tstart) di = i;
  TDesc d;
  d.src = p.td[di].src; d.dst = p.td[di].dst; d.K = p.td[di].K; d.N = p.td[di].N; d.Npad = p.td[di].Npad;
  d.nb = p.td[di].nb; d.tstart = p.td[di].tstart; d.per = p.td[di].per; d.ldd = p.td[di].ldd;
  int r = t - d.tstart;
  int batch = r / d.per; r -= batch * d.per;
  const int tk = d.K >> 6;
  const int kt = r % tk, nt = r / tk;
  const float* src = d.src + (size_t)batch * d.K * d.N;
  u16* dst = d.dst + (size_t)batch * d.Npad * d.ldd;
  float* tr = (float*)smem;
  const int tid = tid_opaque(wv);
  const int k0 = kt * 64, n0 = nt * 64;
  {
    const int rr = tid >> 4, c4 = tid & 15;
#pragma unroll
    for (int i = 0; i < 4; ++i) {
      const int k = rr + 16 * i;
      const int n = n0 + c4 * 4;
      float4 v = make_float4(0.f, 0.f, 0.f, 0.f);
      if (n < d.N) v = *(const float4*)(src + (size_t)(k0 + k) * d.N + n);
      tr[k * 65 + c4 * 4 + 0] = v.x; tr[k * 65 + c4 * 4 + 1] = v.y;
      tr[k * 65 + c4 * 4 + 2] = v.z; tr[k * 65 + c4 * 4 + 3] = v.w;
    }
  }
  __syncthreads();
  {
    const int n = tid >> 2, kq = tid & 3;
    u32 w[8];
#pragma unroll
    for (int j = 0; j < 8; ++j)
      w[j] = pack2(tr[(kq * 16 + 2 * j) * 65 + n], tr[(kq * 16 + 2 * j + 1) * 65 + n]);
    u16* o = dst + (size_t)(n0 + n) * d.ldd + k0 + kq * 16;
    *(u32x4*)(o) = u32x4{w[0], w[1], w[2], w[3]};
    *(u32x4*)(o + 8) = u32x4{w[4], w[5], w[6], w[7]};
  }
  __syncthreads();
}

__device__ void adaln_item(int wv, PRM p, char* smem, int it) {
  const int l = it / 96, jb = it % 96;
  const int tid = tid_opaque(wv), col = tid & 31, kg = tid >> 5;
  float* sc = (float*)smem;
  float* red = sc + 17 * 512;
  const float* W = p.in[12] + (size_t)l * 1024 * 3072 + jb * 32 + col;
  float acc[17];
#pragma unroll
  for (int b = 0; b < 17; ++b) acc[b] = 0.f;
  for (int half = 0; half < 2; ++half) {
    __syncthreads();
    for (int i = tid; i < 17 * 512; i += NTHR) {
      const int b = i >> 9, k = (i & 511) + half * 512;
      const float c = (b == 0) ? p.in[2][k] : p.in[3][(b - 1) * 1024 + k];
      sc[i] = siluf_(c);
    }
    __syncthreads();
#pragma unroll 1
    for (int k0 = 0; k0 < 64; k0 += 16) {
      float wv16[16];
#pragma unroll
      for (int kk = 0; kk < 16; ++kk) wv16[kk] = W[(size_t)(half * 512 + kg * 64 + k0 + kk) * 3072];
#pragma unroll
      for (int kk = 0; kk < 16; ++kk) {
        const int kl = kg * 64 + k0 + kk;
#pragma unroll
        for (int b = 0; b < 17; ++b) acc[b] += sc[b * 512 + kl] * wv16[kk];
      }
    }
  }
#pragma unroll
  for (int b = 0; b < 17; ++b) red[(kg * 17 + b) * 32 + col] = acc[b];
  __syncthreads();
  for (int i = tid; i < 17 * 32; i += NTHR) {
    const int b = i >> 5, c = i & 31;
    float v = 0.f;
#pragma unroll
    for (int g = 0; g < 8; ++g) v += red[(g * 17 + b) * 32 + c];
    p.MODS[(size_t)(l * 17 + b) * 3072 + jb * 32 + c] = v + p.in[13][l * 3072 + jb * 32 + c];
  }
  __syncthreads();
}

__device__ void prologue_phase(int wv, PRM p, char* smem) {
  const int total = p.ntr + 384;
  for (int it = blockIdx.x; it < total; it += gridDim.x) {
    if (it < 384) adaln_item(wv, p, smem, it);
    else transpose_tile(wv, p, smem, it - 384);
  }
}

__device__ void norm_phase(int wv, PRM p, int li) {
  const int tid = tid_opaque(wv);
  const int wave = tid >> 6, lane = tid & 63;
  for (int row = blockIdx.x * 4 + wave; row < NT; row += gridDim.x * 4) {
    const float* xr = (li == 0) ? (row < SP ? p.in[0] + (size_t)row * 1024 : p.in[1] + (size_t)(row - SP) * 1024)
                                : p.y + (size_t)row * 1024;
    float4 v[4];
    float ss = 0.f;
#pragma unroll
    for (int i = 0; i < 4; ++i) {
      v[i] = *(const float4*)(xr + lane * 4 + i * 256);
      ss += v[i].x * v[i].x + v[i].y * v[i].y + v[i].z * v[i].z + v[i].w * v[i].w;
    }
    ss = wave_sum(ss);
    const float rstd = rsqrtf(ss * (1.f / 1024.f) + 1e-6f);
    if (li < 4) {
      const int b = seqid(row);
      const float* shift = p.MODS + (size_t)(li * 17 + b) * 3072;
      const float* scale = shift + 1024;
      const float* nw = p.in[11] + li * 1024;
#pragma unroll
      for (int i = 0; i < 4; ++i) {
        const int k = lane * 4 + i * 256;
        const float4 w4 = *(const float4*)(nw + k);
        const float4 s4 = *(const float4*)(scale + k);
        const float4 h4 = *(const float4*)(shift + k);
        const float a0 = v[i].x * rstd * w4.x * (1.f + s4.x) + h4.x;
        const float a1 = v[i].y * rstd * w4.y * (1.f + s4.y) + h4.y;
        const float a2 = v[i].z * rstd * w4.z * (1.f + s4.z) + h4.z;
        const float a3 = v[i].w * rstd * w4.w * (1.f + s4.w) + h4.w;
        *(u32x2*)(p.HC + (size_t)row * 1024 + k) = u32x2{pack2(a0, a1), pack2(a2, a3)};
      }
    } else {
      const float* fw = p.in[32];
#pragma unroll
      for (int i = 0; i < 4; ++i) {
        const int k = lane * 4 + i * 256;
        const float4 w4 = *(const float4*)(fw + k);
        float4 o;
        o.x = v[i].x * rstd * w4.x; o.y = v[i].y * rstd * w4.y;
        o.z = v[i].z * rstd * w4.z; o.w = v[i].w * rstd * w4.w;
        *(float4*)(p.y + (size_t)row * 1024 + k) = o;
      }
    }
  }
}

#define EPI_INEVEN 0
#define EPI_OUT 1
#define EPI_INODD 2

template <int EPI>
__device__ __forceinline__ void gemm_store(PRM p, int li, int tb, int col, f32x4 v) {
  if (EPI == EPI_INEVEN) {
    const int ei = li >> 1;
    const int region = col >> 10, c = col & 1023;
    if (region == 9) {
      if (c < 16) {
#pragma unroll
        for (int j = 0; j < 4; ++j) p.GATES[(size_t)(tb + j) * 16 + c] = v[j];
      }
      return;
    }
    u16* reg = p.PROJ + (size_t)region * NT * 1024;
    if (region == 2 || region == 6) {
      const int key = tb & 63;
      const int pos = (key >> 5) * 32 + ((key >> 2) & 3) * 8 + ((key >> 4) & 1) * 4;
      *(u32x2*)(reg + (size_t)c * NT + (tb & ~63) + pos) = u32x2{pack2(v[0], v[1]), pack2(v[2], v[3])};
    } else {
      const float sc = (region == 5) ? 0.08838834764831845f : 1.f;
#pragma unroll
      for (int j = 0; j < 4; ++j) reg[(size_t)(tb + j) * 1024 + c] = f2bf(v[j] * sc);
    }
    if (region == 1 || region == 2) {
      float* op = (region == 1) ? p.kp : p.vp;
      float* os = (region == 1) ? p.ks : p.vs;
#pragma unroll
      for (int j = 0; j < 4; ++j) {
        const int tok = tb + j;
        if (tok < SP) op[((size_t)ei * SP + tok) * 1024 + c] = v[j];
        else os[((size_t)ei * 512 + (tok - SP)) * 1024 + c] = v[j];
      }
    }
  } else if (EPI == EPI_OUT) {
#pragma unroll
    for (int j = 0; j < 4; ++j) {
      const int tok = tb + j;
      const int b = seqid(tok);
      const float g = p.MODS[(size_t)(li * 17 + b) * 3072 + 2048 + col];
      float xres;
      if (li == 0) xres = (tok < SP) ? p.in[0][(size_t)tok * 1024 + col] : p.in[1][(size_t)(tok - SP) * 1024 + col];
      else xres = p.y[(size_t)tok * 1024 + col];
      p.y[(size_t)tok * 1024 + col] = xres + g * v[j];
    }
  } else {
#pragma unroll
    for (int j = 0; j < 4; ++j) p.PROJ[(size_t)(tb + j) * 4096 + col] = f2bf(v[j]);
  }
}

template <int EPI, int BM>
__device__ void gemm_phase(int wv, PRM p, char* smem, const u16* __restrict__ A, int lda,
                           const u16* __restrict__ Bt, int ldb, int K, int ntn, int li) {
  constexpr int MT = BM / 32;
  constexpr int NA = BM / 64;
  constexpr int STG = (BM + 128) * 64;
  constexpr int NM = NT / BM;
  const int tid = tid_opaque(wv), lane = tid & 63, w = tid >> 6;
  const int wr = w >> 1, wc = w & 1, l15 = lane & 15, q4 = lane >> 4;
  const int total = NM * ntn;
  const int nloc = gridDim.x >> 3;
  const int nk = K >> 5;
  const int gk = (0x1320 >> ((lane >> 4) * 4)) & 3;
  const int dsw = ((lane & 3) ^ gk) * 8;
  const int fk = (0x1320 >> ((l15 >> 2) * 4)) & 3;
  const int po = (q4 ^ fk) * 16;
  for (int it = 0;; ++it) {
    const int base = it * 8 * nloc;
    if (base >= total) break;
    const int Lidx = (it * 8 + (blockIdx.x & 7)) * nloc + (blockIdx.x >> 3);
    if (Lidx >= total) continue;
    const int g = Lidx / (8 * ntn), r = Lidx - g * 8 * ntn;
    const int gsz = min(8, NM - g * 8);
    const int tm = g * 8 + r % gsz, tn = r / gsz;
    const int m0 = tm * BM, n0 = tn * 128;
    f32x4 acc[MT][4];
#pragma unroll
    for (int m = 0; m < MT; ++m)
#pragma unroll
      for (int n = 0; n < 4; ++n) acc[m][n] = f32x4{0.f, 0.f, 0.f, 0.f};
    const u16* Ag = A + (size_t)(m0 + w * NA * 16 + (lane >> 2)) * lda + dsw;
    const u16* Bg = Bt + (size_t)(n0 + w * 32 + (lane >> 2)) * ldb + dsw;
#define G_DMA(KT, ST)                                                                              \
  {                                                                                                \
    _Pragma("unroll") for (int i = 0; i < NA; ++i)                                                 \
      __builtin_amdgcn_global_load_lds((const unsigned*)(Ag + (size_t)(i * 16) * lda + (KT) * 32), \
          (LAS unsigned*)(smem + (ST) * STG + (w * NA + i) * 1024 + lane * 16), 16, 0, 0);         \
    _Pragma("unroll") for (int i = 0; i < 2; ++i)                                                  \
      __builtin_amdgcn_global_load_lds((const unsigned*)(Bg + (size_t)(i * 16) * ldb + (KT) * 32),   \
          (LAS unsigned*)(smem + (ST) * STG + BM * 64 + (w * 2 + i) * 1024 + lane * 16), 16, 0, 0); \
  }
    asm volatile("s_waitcnt vmcnt(0)" ::: "memory");
    __syncthreads();
    constexpr int NS = (BM == 256) ? 3 : 4;
    G_DMA(0, 0)
    G_DMA(1, 1)
    if (NS == 4) { G_DMA(2, 2) }
    int st = 0;
    for (int kt = 0; kt < nk; ++kt) {
      const int rem = nk - 1 - kt;
      if (BM == 256) {
        if (rem >= 1) asm volatile("s_waitcnt vmcnt(6)" ::: "memory");
        else asm volatile("s_waitcnt vmcnt(0)" ::: "memory");
      } else {
        if (rem >= 2) asm volatile("s_waitcnt vmcnt(8)" ::: "memory");
        else if (rem == 1) asm volatile("s_waitcnt vmcnt(4)" ::: "memory");
        else asm volatile("s_waitcnt vmcnt(0)" ::: "memory");
      }
      __builtin_amdgcn_s_barrier();
      if (kt + NS - 1 < nk) {
        const int s2 = (st >= 1) ? st - 1 : NS - 1;
        G_DMA(kt + NS - 1, s2)
      }
      __builtin_amdgcn_sched_barrier(0);
      const char* cA = smem + st * STG + (wr * (BM / 2) + l15) * 64 + po;
      const char* cB = smem + st * STG + BM * 64 + (wc * 64 + l15) * 64 + po;
      bf16x8 af[MT], bfr[4];
      const unsigned aA = (unsigned)(size_t)(LAS const char*)cA, aB = (unsigned)(size_t)(LAS const char*)cB;
#pragma unroll
      for (int m = 0; m < MT; ++m)
        asm volatile("ds_read_b128 %0, %1 offset:%2" : "=v"(af[m]) : "v"(aA), "i"(m * 16 * 64));
#pragma unroll
      for (int n = 0; n < 4; ++n)
        asm volatile("ds_read_b128 %0, %1 offset:%2" : "=v"(bfr[n]) : "v"(aB), "i"(n * 16 * 64));
      if (MT == 8)
        asm volatile("s_waitcnt lgkmcnt(0)" : "+v"(af[0]), "+v"(af[1]), "+v"(af[2]), "+v"(af[3]), "+v"(af[MT - 4]), "+v"(af[MT - 3]),
                     "+v"(af[MT - 2]), "+v"(af[MT - 1]), "+v"(bfr[0]), "+v"(bfr[1]), "+v"(bfr[2]), "+v"(bfr[3]));
      else
        asm volatile("s_waitcnt lgkmcnt(0)" : "+v"(af[0]), "+v"(af[1]), "+v"(af[2]), "+v"(af[3]), "+v"(bfr[0]), "+v"(bfr[1]),
                     "+v"(bfr[2]), "+v"(bfr[3]));
      __builtin_amdgcn_s_setprio(1);
#pragma unroll
      for (int m = 0; m < MT; ++m)
#pragma unroll
        for (int n = 0; n < 4; ++n) acc[m][n] = mfma16(af[m], bfr[n], acc[m][n]);
      __builtin_amdgcn_s_setprio(0);
      st = (st == NS - 1) ? 0 : st + 1;
    }
#undef G_DMA
#pragma unroll
    for (int m = 0; m < MT; ++m)
#pragma unroll
      for (int n = 0; n < 4; ++n)
        gemm_store<EPI>(p, li, m0 + wr * (BM / 2) + m * 16 + q4 * 4, n0 + wc * 64 + n * 16 + l15, acc[m][n]);
  }
}

template <int NQT, bool SAMPLE>
__device__ void attn_item(int wv, PRM p, char* smem, int ei, int h, int idx, float lam, float lam_init) {
  const int tid = tid_opaque(wv), lane = tid & 63, w = tid >> 6;
  const int c = w & 1, qh = w >> 1, l15 = lane & 15, q4 = lane >> 4;
  u16* sK = (u16*)smem;
  u16* sV = sK + 64 * 136;
  const u16* Qg = p.PROJ;
  const u16* Kg = p.PROJ + (size_t)1 * NT * 1024;
  const u16* Vtg = p.PROJ + (size_t)2 * NT * 1024;
  const u16* Zg = p.PROJ + (size_t)3 * NT * 1024;
  constexpr int QW = NQT * 16;
  const int tokq0 = SAMPLE ? SP + idx * 32 : idx * 64;
  u16* sQ = sV + 128 * 72;
#pragma unroll
  for (int i = 0; i < NQT * 2; ++i) {
    const int id = tid + i * 256;
    *(u32x4*)(sQ + (id >> 4) * 136 + (id & 15) * 8) =
        *(const u32x4*)(Qg + (size_t)(tokq0 + (id >> 4)) * 1024 + h * 128 + (id & 15) * 8);
  }
  f32x4 o[8][NQT];
  float m_run[NQT], l_run[NQT];
#pragma unroll
  for (int qt = 0; qt < NQT; ++qt) {
    m_run[qt] = -1e30f; l_run[qt] = 0.f;
#pragma unroll
    for (int et = 0; et < 8; ++et) o[et][qt] = f32x4{0.f, 0.f, 0.f, 0.f};
  }
  const int nkt = SAMPLE ? 17 : idx + 1;
  const float SC = 0.125f * 1.4426950408889634f;
  u32x4 rk[4], rv[4];
  float4 fk[8], fv[8];
  if (SAMPLE) {
    const float* ck = p.in[4] + ((size_t)(ei * 16 + idx) * 1024) * 1024 + h * 128;
    const float* cv = p.in[5] + ((size_t)(ei * 16 + idx) * 1024) * 1024 + h * 128;
#pragma unroll
    for (int i = 0; i < 8; ++i) {
      const int id = tid + i * 256;
      fk[i] = *(const float4*)(ck + (size_t)(id >> 5) * 1024 + (id & 31) * 4);
      fv[i] = *(const float4*)(cv + (size_t)(id & 63) * 1024 + (id >> 6) * 4);
    }
  }
  if (!SAMPLE) {
#pragma unroll
    for (int i = 0; i < 4; ++i) {
      const int id = tid + i * 256;
      rk[i] = *(const u32x4*)(Kg + (size_t)(0 * 64 + (id >> 4)) * 1024 + h * 128 + (id & 15) * 8);
      rv[i] = *(const u32x4*)(Vtg + (size_t)(h * 128 + (id >> 3)) * NT + 0 * 64 + (id & 7) * 8);
    }
  }
  for (int kt = 0; kt < nkt; ++kt) {
    __syncthreads();
    int nmt = 4;
    if (!SAMPLE) {
#pragma unroll
      for (int i = 0; i < 4; ++i) {
        const int id = tid + i * 256;
        *(u32x4*)(sK + (id >> 4) * 136 + (id & 15) * 8) = rk[i];
        *(u32x4*)(sV + (id >> 3) * 72 + (id & 7) * 8) = rv[i];
      }
    } else {
      if (kt < 16) {
#pragma unroll
        for (int i = 0; i < 8; ++i) {
          const int id = tid + i * 256;
          const int key = id >> 5, c4 = id & 31;
          *(u32x2*)(sK + key * 136 + c4 * 4) = u32x2{pack2(fk[i].x, fk[i].y), pack2(fk[i].z, fk[i].w)};
        }
#pragma unroll
        for (int i = 0; i < 8; ++i) {
          const int id = tid + i * 256;
          const int key = id & 63, c4 = id >> 6;
          const int kp = (key >> 5) * 32 + ((key >> 2) & 3) * 8 + ((key >> 4) & 1) * 4 + (key & 3);
          sV[(c4 * 4 + 0) * 72 + kp] = f2bf(fv[i].x);
          sV[(c4 * 4 + 1) * 72 + kp] = f2bf(fv[i].y);
          sV[(c4 * 4 + 2) * 72 + kp] = f2bf(fv[i].z);
          sV[(c4 * 4 + 3) * 72 + kp] = f2bf(fv[i].w);
        }
      } else {
        nmt = 2;
        const int tk0 = SP + idx * 32;
#pragma unroll
        for (int i = 0; i < 2; ++i) {
          const int id = tid + i * 256;
          *(u32x4*)(sK + (id >> 4) * 136 + (id & 15) * 8) =
              *(const u32x4*)(Kg + (size_t)(tk0 + (id >> 4)) * 1024 + h * 128 + (id & 15) * 8);
          *(u32x4*)(sV + (id >> 2) * 72 + (id & 3) * 8) =
              *(const u32x4*)(Vtg + (size_t)(h * 128 + (id >> 2)) * NT + tk0 + (id & 3) * 8);
        }
      }
    }
    __syncthreads();
    if (!SAMPLE) {
      if (kt + 1 < nkt) {
#pragma unroll
        for (int i = 0; i < 4; ++i) {
          const int id = tid + i * 256;
          rk[i] = *(const u32x4*)(Kg + (size_t)((kt + 1) * 64 + (id >> 4)) * 1024 + h * 128 + (id & 15) * 8);
          rv[i] = *(const u32x4*)(Vtg + (size_t)(h * 128 + (id >> 3)) * NT + (kt + 1) * 64 + (id & 7) * 8);
        }
      }
    } else {
      if (kt + 1 < 16) {
        const float* ck = p.in[4] + ((size_t)(ei * 16 + idx) * 1024 + (kt + 1) * 64) * 1024 + h * 128;
        const float* cv = p.in[5] + ((size_t)(ei * 16 + idx) * 1024 + (kt + 1) * 64) * 1024 + h * 128;
#pragma unroll
        for (int i = 0; i < 8; ++i) {
          const int id = tid + i * 256;
          fk[i] = *(const float4*)(ck + (size_t)(id >> 5) * 1024 + (id & 31) * 4);
          fv[i] = *(const float4*)(cv + (size_t)(id & 63) * 1024 + (id >> 6) * 4);
        }
      }
    }
    __builtin_amdgcn_sched_barrier(0);
    f32x4 s[4][NQT];
    bf16x8 kf[4][2];
    bf16x8 qf[NQT][2];
#pragma unroll
    for (int qt = 0; qt < NQT; ++qt)
#pragma unroll
      for (int ks = 0; ks < 2; ++ks)
        qf[qt][ks] = *(const bf16x8*)(sQ + (qh * QW + qt * 16 + l15) * 136 + c * 64 + ks * 32 + q4 * 8);
#pragma unroll
    for (int mt = 0; mt < 4; ++mt)
#pragma unroll
      for (int ks = 0; ks < 2; ++ks)
        kf[mt][ks] = *(const bf16x8*)(sK + (mt * 16 + l15) * 136 + c * 64 + ks * 32 + q4 * 8);
    __builtin_amdgcn_sched_barrier(0);
    __builtin_amdgcn_s_setprio(1);
#pragma unroll
    for (int mt = 0; mt < 4; ++mt)
#pragma unroll
      for (int qt = 0; qt < NQT; ++qt) {
        s[mt][qt] = f32x4{0.f, 0.f, 0.f, 0.f};
        if (mt < nmt) {
#pragma unroll
          for (int ks = 0; ks < 2; ++ks) s[mt][qt] = mfma16(kf[mt][ks], qf[qt][ks], s[mt][qt]);
        }
      }
    __builtin_amdgcn_s_setprio(0);
    __builtin_amdgcn_sched_barrier(0);
    u32 pw[NQT][8];
#pragma unroll
    for (int qt = 0; qt < NQT; ++qt) {
      float mx = -1e30f;
#pragma unroll
      for (int mt = 0; mt < 4; ++mt)
        if (mt < nmt) {
#pragma unroll
          for (int j = 0; j < 4; ++j) mx = fmaxf(mx, s[mt][qt][j]);
        }
      mx = red16_max(mx) * SC;
      const float mnew = fmaxf(m_run[qt], mx);
      const float alpha = __builtin_amdgcn_exp2f(m_run[qt] - mnew);
      m_run[qt] = mnew;
      float psum = 0.f;
#pragma unroll
      for (int mt = 0; mt < 4; ++mt) {
#pragma unroll
        for (int j = 0; j < 4; ++j) {
          float pv = 0.f;
          if (mt < nmt) pv = __builtin_amdgcn_exp2f(s[mt][qt][j] * SC - mnew);
          psum += pv;
          s[mt][qt][j] = pv;
        }
        pw[qt][mt * 2 + 0] = pack2(s[mt][qt][0], s[mt][qt][1]);
        pw[qt][mt * 2 + 1] = pack2(s[mt][qt][2], s[mt][qt][3]);
      }
      l_run[qt] = l_run[qt] * alpha + psum;
      if (__builtin_amdgcn_ballot_w64(alpha != 1.f) != 0ull) {
#pragma unroll
        for (int et = 0; et < 8; ++et) o[et][qt] *= alpha;
      }
    }
    __builtin_amdgcn_sched_barrier(0);
    bf16x8 vf[8];
#pragma unroll
    for (int et = 0; et < 8; ++et) vf[et] = *(const bf16x8*)(sV + (et * 16 + l15) * 72 + q4 * 8);
    __builtin_amdgcn_sched_barrier(0);
    __builtin_amdgcn_s_setprio(1);
#pragma unroll
    for (int et = 0; et < 8; ++et) {
      const bf16x8 a = vf[et];
#pragma unroll
      for (int qt = 0; qt < NQT; ++qt) {
        const bf16x8 b = mk8(pw[qt][0], pw[qt][1], pw[qt][2], pw[qt][3]);
        o[et][qt] = mfma16(a, b, o[et][qt]);
      }
    }
    __builtin_amdgcn_s_setprio(0);
    __builtin_amdgcn_sched_barrier(0);
    if (nmt > 2) {
#pragma unroll
      for (int et = 0; et < 8; ++et) vf[et] = *(const bf16x8*)(sV + (et * 16 + l15) * 72 + 32 + q4 * 8);
      __builtin_amdgcn_sched_barrier(0);
      __builtin_amdgcn_s_setprio(1);
#pragma unroll
      for (int et = 0; et < 8; ++et) {
        const bf16x8 a = vf[et];
#pragma unroll
        for (int qt = 0; qt < NQT; ++qt) {
          const bf16x8 b = mk8(pw[qt][4], pw[qt][5], pw[qt][6], pw[qt][7]);
          o[et][qt] = mfma16(a, b, o[et][qt]);
        }
      }
      __builtin_amdgcn_s_setprio(0);
    }
  }
  float inv[NQT];
#pragma unroll
  for (int qt = 0; qt < NQT; ++qt) inv[qt] = rcpf_(red16_sum(l_run[qt]));
  float* exch = (float*)smem;
  __syncthreads();
  if (c == 1) {
#pragma unroll
    for (int qt = 0; qt < NQT; ++qt)
#pragma unroll
      for (int et = 0; et < 8; ++et)
#pragma unroll
        for (int j = 0; j < 4; ++j)
          exch[(qh * 128 + et * 16 + q4 * 4 + j) * QW + qt * 16 + l15] = o[et][qt][j] * inv[qt];
  }
  __syncthreads();
  if (c == 0) {
    const float* subw = p.in[20] + ei * 128;
#pragma unroll
    for (int qt = 0; qt < NQT; ++qt) {
      const int tok = tokq0 + qh * QW + qt * 16 + l15;
      float ss = 0.f;
#pragma unroll
      for (int et = 0; et < 8; ++et)
#pragma unroll
        for (int j = 0; j < 4; ++j) {
          const float v = o[et][qt][j] * inv[qt] -
                          lam * exch[(qh * 128 + et * 16 + q4 * 4 + j) * QW + qt * 16 + l15];
          o[et][qt][j] = v;
          ss += v * v;
        }
      ss = red16_sum(ss);
      const float rstd = rsqrtf(ss * (1.f / 128.f) + 1e-6f) * (1.f - lam_init);
#pragma unroll
      for (int et = 0; et < 8; ++et) {
        const int e0 = et * 16 + q4 * 4;
        const u32x2 zz = *(const u32x2*)(Zg + (size_t)tok * 1024 + h * 128 + e0);
        const float4 sw4 = *(const float4*)(subw + e0);
        const float r0 = o[et][qt][0] * rstd * sw4.x * siluf_(bflo(zz[0]));
        const float r1 = o[et][qt][1] * rstd * sw4.y * siluf_(bfhi(zz[0]));
        const float r2 = o[et][qt][2] * rstd * sw4.z * siluf_(bflo(zz[1]));
        const float r3 = o[et][qt][3] * rstd * sw4.w * siluf_(bfhi(zz[1]));
        *(u32x2*)(p.HC + (size_t)tok * PCC + h * 128 + e0) = u32x2{pack2(r0, r1), pack2(r2, r3)};
      }
    }
  }
  __syncthreads();
}

__device__ void attn_prompt_item(int wv, PRM p, char* smem, int ei, int h, int cq, float lam, float lam_init) {
  const int tid = tid_opaque(wv), lane = tid & 63, w = tid >> 6;
  const int c = w & 1, qh = w >> 1, l15 = lane & 15, q4 = lane >> 4;
  const u16* Qg = p.PROJ;
  const u16* Kg = p.PROJ + (size_t)1 * NT * 1024;
  const u16* Vtg = p.PROJ + (size_t)2 * NT * 1024;
  const u16* Zg = p.PROJ + (size_t)3 * NT * 1024;
  const int tokq0 = cq * 64;
  bf16x8 qf[2][2];
#pragma unroll
  for (int qt = 0; qt < 2; ++qt)
#pragma unroll
    for (int ks = 0; ks < 2; ++ks)
      qf[qt][ks] = *(const bf16x8*)(Qg + (size_t)(tokq0 + qh * 32 + qt * 16 + l15) * 1024 + h * 128 + c * 64 +
                                    ks * 32 + q4 * 8);
  f32x4 o[8][2];
  float m_run[2], l_run[2];
#pragma unroll
  for (int qt = 0; qt < 2; ++qt) {
    m_run[qt] = -1e30f; l_run[qt] = 0.f;
#pragma unroll
    for (int et = 0; et < 8; ++et) o[et][qt] = f32x4{0.f, 0.f, 0.f, 0.f};
  }
  const int nkt = cq + 1;
  const float SC = 0.125f * 1.4426950408889634f;
  const u16* Ksrc = Kg + (size_t)(w * 16 + (lane >> 4)) * 1024 + h * 128;
  const u16* Vsrc = Vtg + (size_t)(h * 128 + w * 32 + (lane >> 3)) * NT;
  const int vsw0 = ((lane & 7) ^ ((lane >> 4) & 7)) * 8, vsw1 = ((lane & 7) ^ ((4 + (lane >> 4)) & 7)) * 8;
#define A_DMA(KT, ST)                                                                                   \
  _Pragma("unroll") for (int i = 0; i < 4; ++i) {                                                       \
    const int ksw = ((lane & 15) ^ (i * 4 + (lane >> 4))) * 8;                                          \
    __builtin_amdgcn_global_load_lds((const unsigned*)(Ksrc + (size_t)((KT) * 64 + i * 4) * 1024 + ksw), \
        (LAS unsigned*)(smem + (ST) * 32768 + (w * 4 + i) * 1024 + lane * 16), 16, 0, 0);               \
    __builtin_amdgcn_global_load_lds((const unsigned*)(Vsrc + (size_t)(i * 8) * NT + (KT) * 64 + ((i & 1) ? vsw1 : vsw0)), \
        (LAS unsigned*)(smem + (ST) * 32768 + 16384 + (w * 4 + i) * 1024 + lane * 16), 16, 0, 0);       \
  }
  A_DMA(0, 0)
  const unsigned ldsb = (unsigned)(size_t)(LAS const char*)smem;
  const unsigned aK0 = ldsb + l15 * 256 + (((c * 8 + 0 * 4 + q4) ^ l15) * 16);
  const unsigned aK1 = ldsb + l15 * 256 + (((c * 8 + 1 * 4 + q4) ^ l15) * 16);
  const unsigned aV0 = ldsb + 16384 + l15 * 128 + (((0 * 4 + q4) ^ (l15 >> 1)) * 16);
  const unsigned aV1 = ldsb + 16384 + l15 * 128 + (((1 * 4 + q4) ^ (l15 >> 1)) * 16);
  for (int kt = 0; kt < nkt; ++kt) {
    const unsigned so = (kt & 1) * 32768;
    asm volatile("s_waitcnt vmcnt(0)" ::: "memory");
    __builtin_amdgcn_s_barrier();
    if (kt + 1 < nkt) { A_DMA(kt + 1, (kt + 1) & 1) }
    bf16x8 kf[4][2];
#pragma unroll
    for (int mt = 0; mt < 4; ++mt) {
      asm volatile("ds_read_b128 %0, %1 offset:%2" : "=v"(kf[mt][0]) : "v"(aK0 + so), "i"(mt * 4096));
      asm volatile("ds_read_b128 %0, %1 offset:%2" : "=v"(kf[mt][1]) : "v"(aK1 + so), "i"(mt * 4096));
    }
    asm volatile("s_waitcnt lgkmcnt(0)" : "+v"(kf[0][0]), "+v"(kf[0][1]), "+v"(kf[1][0]), "+v"(kf[1][1]), "+v"(kf[2][0]),
                 "+v"(kf[2][1]), "+v"(kf[3][0]), "+v"(kf[3][1]));
    f32x4 s[4][2];
    __builtin_amdgcn_s_setprio(1);
#pragma unroll
    for (int mt = 0; mt < 4; ++mt)
#pragma unroll
      for (int qt = 0; qt < 2; ++qt) {
        s[mt][qt] = f32x4{0.f, 0.f, 0.f, 0.f};
#pragma unroll
        for (int ks = 0; ks < 2; ++ks) s[mt][qt] = mfma16(kf[mt][ks], qf[qt][ks], s[mt][qt]);
      }
    __builtin_amdgcn_s_setprio(0);
    __builtin_amdgcn_sched_barrier(0);
    bf16x8 vf[8];
#pragma unroll
    for (int et = 0; et < 8; ++et)
      asm volatile("ds_read_b128 %0, %1 offset:%2" : "=v"(vf[et]) : "v"(aV0 + so), "i"(et * 2048));
    u32 pw[2][8];
#pragma unroll
    for (int qt = 0; qt < 2; ++qt) {
      float mx = -1e30f;
#pragma unroll
      for (int mt = 0; mt < 4; ++mt)
#pragma unroll
        for (int j = 0; j < 4; ++j) mx = fmaxf(mx, s[mt][qt][j]);
      mx = red16_max(mx) * SC;
      const float mnew = fmaxf(m_run[qt], mx);
      const float alpha = __builtin_amdgcn_exp2f(m_run[qt] - mnew);
      m_run[qt] = mnew;
      float psum = 0.f;
#pragma unroll
      for (int mt = 0; mt < 4; ++mt) {
#pragma unroll
        for (int j = 0; j < 4; ++j) {
          const float pv = __builtin_amdgcn_exp2f(s[mt][qt][j] * SC - mnew);
          psum += pv;
          s[mt][qt][j] = pv;
        }
        pw[qt][mt * 2 + 0] = pack2(s[mt][qt][0], s[mt][qt][1]);
        pw[qt][mt * 2 + 1] = pack2(s[mt][qt][2], s[mt][qt][3]);
      }
      l_run[qt] = l_run[qt] * alpha + psum;
      if (__builtin_amdgcn_ballot_w64(alpha != 1.f) != 0ull) {
#pragma unroll
        for (int et = 0; et < 8; ++et) o[et][qt] *= alpha;
      }
    }
    __builtin_amdgcn_sched_barrier(0);
#pragma unroll
    for (int ks2 = 0; ks2 < 2; ++ks2) {
      if (ks2 == 1) {
#pragma unroll
        for (int et = 0; et < 8; ++et)
          asm volatile("ds_read_b128 %0, %1 offset:%2" : "=v"(vf[et]) : "v"(aV1 + so), "i"(et * 2048));
      }
      asm volatile("s_waitcnt lgkmcnt(0)" : "+v"(vf[0]), "+v"(vf[1]), "+v"(vf[2]), "+v"(vf[3]), "+v"(vf[4]), "+v"(vf[5]),
                   "+v"(vf[6]), "+v"(vf[7]));
      __builtin_amdgcn_s_setprio(1);
#pragma unroll
      for (int et = 0; et < 8; ++et)
#pragma unroll
        for (int qt = 0; qt < 2; ++qt) {
          const bf16x8 b = mk8(pw[qt][ks2 * 4 + 0], pw[qt][ks2 * 4 + 1], pw[qt][ks2 * 4 + 2], pw[qt][ks2 * 4 + 3]);
          o[et][qt] = mfma16(vf[et], b, o[et][qt]);
        }
      __builtin_amdgcn_s_setprio(0);
      __builtin_amdgcn_sched_barrier(0);
    }
  }
#undef A_DMA
  float inv[2];
#pragma unroll
  for (int qt = 0; qt < 2; ++qt) inv[qt] = rcpf_(red16_sum(l_run[qt]));
  float* exch = (float*)smem;
  __syncthreads();
  if (c == 1) {
#pragma unroll
    for (int qt = 0; qt < 2; ++qt)
#pragma unroll
      for (int et = 0; et < 8; ++et)
#pragma unroll
        for (int j = 0; j < 4; ++j)
          exch[(qh * 128 + et * 16 + q4 * 4 + j) * 32 + qt * 16 + l15] = o[et][qt][j] * inv[qt];
  }
  __syncthreads();
  if (c == 0) {
    const float* subw = p.in[20] + ei * 128;
#pragma unroll
    for (int qt = 0; qt < 2; ++qt) {
      const int tok = tokq0 + qh * 32 + qt * 16 + l15;
      float ss = 0.f;
#pragma unroll
      for (int et = 0; et < 8; ++et)
#pragma unroll
        for (int j = 0; j < 4; ++j) {
          const float v = o[et][qt][j] * inv[qt] - lam * exch[(qh * 128 + et * 16 + q4 * 4 + j) * 32 + qt * 16 + l15];
          o[et][qt][j] = v;
          ss += v * v;
        }
      ss = red16_sum(ss);
      const float rstd = rsqrtf(ss * (1.f / 128.f) + 1e-6f) * (1.f - lam_init);
#pragma unroll
      for (int et = 0; et < 8; ++et) {
        const int e0 = et * 16 + q4 * 4;
        const u32x2 zz = *(const u32x2*)(Zg + (size_t)tok * 1024 + h * 128 + e0);
        const float4 sw4 = *(const float4*)(subw + e0);
        const float r0 = o[et][qt][0] * rstd * sw4.x * siluf_(bflo(zz[0]));
        const float r1 = o[et][qt][1] * rstd * sw4.y * siluf_(bfhi(zz[0]));
        const float r2 = o[et][qt][2] * rstd * sw4.z * siluf_(bflo(zz[1]));
        const float r3 = o[et][qt][3] * rstd * sw4.w * siluf_(bfhi(zz[1]));
        *(u32x2*)(p.HC + (size_t)tok * PCC + h * 128 + e0) = u32x2{pack2(r0, r1), pack2(r2, r3)};
      }
    }
  }
  __syncthreads();
}

template <int L>
__device__ __forceinline__ void mlstm_gates(PRM p, int ei, int h, int tok0, int lane, float& ig, float& b) {
  const float* bg = p.in[15] + ei * 16;
  ig = -1e30f;
  float lf = 0.f;
  if (lane < L) {
    const float* g = p.GATES + (size_t)(tok0 + lane) * 16;
    ig = g[h] + bg[h];
    const float f = g[8 + h] + bg[8 + h];
    lf = fminf(f, 0.f) - log1pf(__expf(-fabsf(f)));
  }
  b = lf;
#pragma unroll
  for (int d = 1; d < 64; d <<= 1) {
    const float t = __shfl_up(b, d);
    if (lane >= d) b += t;
  }
}

template <int L>
__device__ void m1_item(int wv, PRM p, char* smem, int ei, int slot, int h, int tok0) {
  const int tid = tid_opaque(wv), lane = tid & 63, w = tid >> 6, l15 = lane & 15, q4 = lane >> 4;
  u16* sKt = (u16*)smem;
  u16* sVt = sKt + 128 * 72;
  float* sws = (float*)(sVt + 128 * 72);
  if (w == 0) {
    float ig, b;
    mlstm_gates<L>(p, ei, h, tok0, lane, ig, b);
    const float blast = __shfl(b, L - 1);
    const float val = (lane < L) ? (blast - b + ig) : -1e30f;
    const float A = wave_max(val);
    if (lane < L) sws[lane] = __expf(val - A);
    if (lane == 0) { p.AB[(slot * 8 + h) * 2] = A; p.AB[(slot * 8 + h) * 2 + 1] = blast; }
  }
  __syncthreads();
  const u16* Kg = p.PROJ + (size_t)5 * NT * 1024;
  const u16* Vg = p.PROJ + (size_t)6 * NT * 1024;
#pragma unroll
  for (int i = 0; i < L * 16 / 256; ++i) {
    const int id = tid + i * 256;
    const int s = id % L, cc = id / L;
    const u32x4 raw = *(const u32x4*)(Kg + (size_t)(tok0 + s) * 1024 + h * 128 + cc * 8);
    const float ws = sws[s];
    const int sp = (s >> 5) * 32 + ((s >> 2) & 3) * 8 + ((s >> 4) & 1) * 4 + (s & 3);
#pragma unroll
    for (int q = 0; q < 4; ++q) {
      sKt[(cc * 8 + 2 * q) * 72 + sp] = f2bf(bflo(raw[q]) * ws);
      sKt[(cc * 8 + 2 * q + 1) * 72 + sp] = f2bf(bfhi(raw[q]) * ws);
    }
  }
  constexpr int CH = L / 8;
#pragma unroll
  for (int i = 0; i < 128 * CH / 256; ++i) {
    const int id = tid + i * 256;
    const int row = id / CH, cc = id % CH;
    *(u32x4*)(sVt + row * 72 + cc * 8) = *(const u32x4*)(Vg + (size_t)(h * 128 + row) * NT + tok0 + cc * 8);
  }
  __syncthreads();
  f32x4 acc[2][8];
#pragma unroll
  for (int mi = 0; mi < 2; ++mi)
#pragma unroll
    for (int nt = 0; nt < 8; ++nt) acc[mi][nt] = f32x4{0.f, 0.f, 0.f, 0.f};
#pragma unroll
  for (int ks = 0; ks < L / 32; ++ks) {
    bf16x8 a[2];
#pragma unroll
    for (int mi = 0; mi < 2; ++mi) a[mi] = *(const bf16x8*)(sKt + ((w * 2 + mi) * 16 + l15) * 72 + ks * 32 + q4 * 8);
#pragma unroll
    for (int nt = 0; nt < 8; ++nt) {
      const bf16x8 b = *(const bf16x8*)(sVt + (nt * 16 + l15) * 72 + ks * 32 + q4 * 8);
#pragma unroll
      for (int mi = 0; mi < 2; ++mi) acc[mi][nt] = mfma16(a[mi], b, acc[mi][nt]);
    }
  }
  u16* U = p.UST + (size_t)(slot * 8 + h) * 16384;
#pragma unroll
  for (int mi = 0; mi < 2; ++mi)
#pragma unroll
    for (int nt = 0; nt < 8; ++nt) {
      const int d0 = (w * 2 + mi) * 16 + q4 * 4, e = nt * 16 + l15;
      *(u32x2*)(U + e * 128 + d0) = u32x2{pack2(acc[mi][nt][0], acc[mi][nt][1]), pack2(acc[mi][nt][2], acc[mi][nt][3])};
    }
  if (tid < 128) {
    float sum = 0.f;
    for (int s = 0; s < L; ++s) sum += bf2f(sKt[tid * 72 + s]);
    p.NST[(size_t)(slot * 8 + h) * 128 + tid] = sum;
  }
  __syncthreads();
}

__device__ void m2_phase(int wv, PRM p, int ei) {
  for (int it = blockIdx.x; it < 388; it += gridDim.x) {
    const int tid = tid_opaque(wv);
    if (it < 256) {
      const int h = it >> 5;
      const int e = (it & 31) * 4 + (tid >> 6), dp = tid & 63;
      u16* ptr = p.UST + (size_t)h * 16384 + e * 128 + dp * 2;
      const size_t CS = (size_t)8 * 16384;
      const bool wm = ((it & 31) == 0) && tid == 0;
      float m = 0.f, C0 = 0.f, C1 = 0.f;
      for (int c0 = 0; c0 < 256; c0 += 32) {
        u32 u[32]; float A[32], B[32];
#pragma unroll
        for (int k = 0; k < 32; ++k) {
          u[k] = *(const u32*)(ptr + (size_t)(c0 + k) * CS);
          A[k] = p.AB[((c0 + k) * 8 + h) * 2];
          B[k] = p.AB[((c0 + k) * 8 + h) * 2 + 1];
        }
#pragma unroll
        for (int k = 0; k < 32; ++k) {
          const float mnew = fmaxf(B[k] + m, A[k]);
          const float dec = __expf(B[k] + m - mnew), sc = __expf(A[k] - mnew);
          *(u32*)(ptr + (size_t)(c0 + k) * CS) = pack2(C0, C1);
          if (wm) p.MST[(c0 + k) * 8 + h] = m;
          C0 = dec * C0 + sc * bflo(u[k]);
          C1 = dec * C1 + sc * bfhi(u[k]);
          m = mnew;
        }
      }
      p.mcp[((size_t)(ei * 8 + h) * 128 + 2 * dp) * 128 + e] = C0;
      p.mcp[((size_t)(ei * 8 + h) * 128 + 2 * dp + 1) * 128 + e] = C1;
      if (wm) p.mmp[ei * 8 + h] = m;
    } else if (it < 260) {
      const int idx = (it - 256) * 256 + tid;
      const int h = idx >> 7, d = idx & 127;
      float m = 0.f, n = 0.f;
      for (int c0 = 0; c0 < 256; c0 += 16) {
        float nv[16], A[16], B[16];
#pragma unroll
        for (int k = 0; k < 16; ++k) {
          nv[k] = p.NST[(size_t)((c0 + k) * 8 + h) * 128 + d];
          A[k] = p.AB[((c0 + k) * 8 + h) * 2];
          B[k] = p.AB[((c0 + k) * 8 + h) * 2 + 1];
        }
#pragma unroll
        for (int k = 0; k < 16; ++k) {
          const float mnew = fmaxf(B[k] + m, A[k]);
          const float dec = __expf(B[k] + m - mnew), sc = __expf(A[k] - mnew);
          p.NST[(size_t)((c0 + k) * 8 + h) * 128 + d] = n;
          n = dec * n + sc * nv[k];
          m = mnew;
        }
      }
      p.mnp[(ei * 8 + h) * 128 + d] = n;
    } else {
      const int bh = it - 260;
      const int b = bh >> 3, h = bh & 7;
      const int slot = 256 + b;
      const float A = p.AB[(slot * 8 + h) * 2], B = p.AB[(slot * 8 + h) * 2 + 1];
      const float m0 = p.in[8][(ei * 16 + b) * 8 + h];
      const float mnew = fmaxf(B + m0, A);
      const float dec = __expf(B + m0 - mnew), sc = __expf(A - mnew);
      u16* U = p.UST + (size_t)(slot * 8 + h) * 16384;
      const float* c0p = p.in[6] + (size_t)((ei * 16 + b) * 8 + h) * 16384;
      float* co = p.mcs + (size_t)((ei * 16 + b) * 8 + h) * 16384;
      for (int k0 = 0; k0 < 32; k0 += 8) {
        u32 uu[8]; float ca[8], cb[8];
#pragma unroll
        for (int k = 0; k < 8; ++k) {
          const int idx = tid + (k0 + k) * 256;
          const int e = idx >> 6, dp = idx & 63;
          uu[k] = *(const u32*)(U + e * 128 + dp * 2);
          ca[k] = c0p[(2 * dp) * 128 + e];
          cb[k] = c0p[(2 * dp + 1) * 128 + e];
        }
#pragma unroll
        for (int k = 0; k < 8; ++k) {
          const int idx = tid + (k0 + k) * 256;
          const int e = idx >> 6, dp = idx & 63;
          co[(2 * dp) * 128 + e] = dec * ca[k] + sc * bflo(uu[k]);
          co[(2 * dp + 1) * 128 + e] = dec * cb[k] + sc * bfhi(uu[k]);
          *(u32*)(U + e * 128 + dp * 2) = pack2(ca[k], cb[k]);
        }
      }
      if (tid < 128) {
        float* np_ = p.NST + (size_t)(slot * 8 + h) * 128 + tid;
        const float nv = *np_;
        const float n0 = p.in[7][((ei * 16 + b) * 8 + h) * 128 + tid];
        p.mns[((ei * 16 + b) * 8 + h) * 128 + tid] = dec * n0 + sc * nv;
        *np_ = n0;
      }
      if (tid == 0) { p.MST[slot * 8 + h] = m0; p.mms[(ei * 16 + b) * 8 + h] = mnew; }
    }
  }
}

template <int L>
__device__ void m3_item(int wv, PRM p, char* smem, int ei, int slot, int h, int tok0) {
  const int tid = tid_opaque(wv), lane = tid & 63, w = tid >> 6, l15 = lane & 15, q4 = lane >> 4;
  u16* sK = (u16*)smem;
  u16* sV = sK + 64 * 136;
  float* fl = (float*)(sV + 128 * 72);
  float* sgs = fl; float* sM = fl + 64; float* sbt = fl + 128; float* sqn = fl + 192; float* sn0 = fl + 256;
  const u16* Qg = p.PROJ + (size_t)4 * NT * 1024;
  const u16* Kg = p.PROJ + (size_t)5 * NT * 1024;
  const u16* Vg = p.PROJ + (size_t)6 * NT * 1024;
  const u16* Og = p.PROJ + (size_t)7 * NT * 1024;
  const u16* Zg = p.PROJ + (size_t)8 * NT * 1024;
  const float m0 = p.MST[slot * 8 + h];
  if (w == 0) {
    float ig, b;
    mlstm_gates<L>(p, ei, h, tok0, lane, ig, b);
    const float gsv = (lane < L) ? (ig - b) : -1e30f;
    float gm = gsv;
#pragma unroll
    for (int d = 1; d < 64; d <<= 1) {
      const float t = __shfl_up(gm, d);
      if (lane >= d) gm = fmaxf(gm, t);
    }
    if (lane < L) { sgs[lane] = gsv; sM[lane] = fmaxf(m0, gm); sbt[lane] = b; }
  }
  if (tid >= 64 && tid < 192) sn0[tid - 64] = p.NST[(size_t)(slot * 8 + h) * 128 + tid - 64];
#pragma unroll
  for (int i = 0; i < L / 16; ++i) {
    const int id = tid + i * 256;
    *(u32x4*)(sK + (id >> 4) * 136 + (id & 15) * 8) =
        *(const u32x4*)(Kg + (size_t)(tok0 + (id >> 4)) * 1024 + h * 128 + (id & 15) * 8);
  }
  constexpr int CH = L / 8;
#pragma unroll
  for (int i = 0; i < 128 * CH / 256; ++i) {
    const int id = tid + i * 256;
    const int row = id / CH, cc = id % CH;
    *(u32x4*)(sV + row * 72 + cc * 8) = *(const u32x4*)(Vg + (size_t)(h * 128 + row) * NT + tok0 + cc * 8);
  }
  __syncthreads();
  if (tid < L) {
    const u16* q = Qg + (size_t)(tok0 + tid) * 1024 + h * 128;
    float a = 0.f;
#pragma unroll
    for (int cc = 0; cc < 16; ++cc) {
      const u32x4 raw = *(const u32x4*)(q + cc * 8);
#pragma unroll
      for (int k = 0; k < 4; ++k) a += bflo(raw[k]) * sn0[cc * 8 + 2 * k] + bfhi(raw[k]) * sn0[cc * 8 + 2 * k + 1];
    }
    sqn[tid] = a;
  }
  __syncthreads();
  if (w * 16 < L) {
    const int t = w * 16 + l15, tok = tok0 + t;
    bf16x8 qf[4];
#pragma unroll
    for (int ks = 0; ks < 4; ++ks) qf[ks] = *(const bf16x8*)(Qg + (size_t)tok * 1024 + h * 128 + ks * 32 + q4 * 8);
    const float Mt = sM[t];
    const float inter = __expf(m0 - Mt);
    const float bt = sbt[t];
    f32x4 sw[4];
    float den = 0.f;
#pragma unroll
    for (int mt = 0; mt < 4; ++mt) {
      sw[mt] = f32x4{0.f, 0.f, 0.f, 0.f};
      if (mt < L / 16 && mt <= w) {
        f32x4 a4 = f32x4{0.f, 0.f, 0.f, 0.f};
#pragma unroll
        for (int ks = 0; ks < 4; ++ks) {
          const bf16x8 a = *(const bf16x8*)(sK + (mt * 16 + l15) * 136 + ks * 32 + q4 * 8);
          a4 = mfma16(a, qf[ks], a4);
        }
#pragma unroll
        for (int j = 0; j < 4; ++j) {
          const int s = mt * 16 + q4 * 4 + j;
          const float wgt = (s <= t) ? __expf(sgs[s] - Mt) : 0.f;
          sw[mt][j] = a4[j] * wgt;
          den += sw[mt][j];
        }
      }
    }
    den = red16_sum(den) + inter * sqn[t];
    const u16* U = p.UST + (size_t)(slot * 8 + h) * 16384;
    f32x4 acc[8];
#pragma unroll
    for (int eh = 0; eh < 2; ++eh) {
      bf16x8 cf[4][4];
#pragma unroll
      for (int e4 = 0; e4 < 4; ++e4)
#pragma unroll
        for (int ks = 0; ks < 4; ++ks)
          cf[e4][ks] = *(const bf16x8*)(U + ((eh * 4 + e4) * 16 + l15) * 128 + ks * 32 + q4 * 8);
      __builtin_amdgcn_sched_barrier(0);
#pragma unroll
      for (int e4 = 0; e4 < 4; ++e4) {
        const int et = eh * 4 + e4;
        acc[et] = f32x4{0.f, 0.f, 0.f, 0.f};
#pragma unroll
        for (int ks = 0; ks < 4; ++ks) acc[et] = mfma16(cf[e4][ks], qf[ks], acc[et]);
        acc[et] *= inter;
      }
      __builtin_amdgcn_sched_barrier(0);
    }
#pragma unroll
    for (int ks2 = 0; ks2 < L / 32; ++ks2) {
      const bf16x8 b = mk8(pack2(sw[2 * ks2][0], sw[2 * ks2][1]), pack2(sw[2 * ks2][2], sw[2 * ks2][3]),
                           pack2(sw[2 * ks2 + 1][0], sw[2 * ks2 + 1][1]), pack2(sw[2 * ks2 + 1][2], sw[2 * ks2 + 1][3]));
#pragma unroll
      for (int et = 0; et < 8; ++et) {
        const bf16x8 a = *(const bf16x8*)(sV + (et * 16 + l15) * 72 + ks2 * 32 + q4 * 8);
        acc[et] = mfma16(a, b, acc[et]);
      }
    }
    const float denom = fmaxf(fabsf(den), __expf(-(bt + Mt)));
    const float invd = rcpf_(denom);
    float ss = 0.f;
#pragma unroll
    for (int et = 0; et < 8; ++et) {
      const int e0 = et * 16 + q4 * 4;
      const u32x2 og = *(const u32x2*)(Og + (size_t)tok * 1024 + h * 128 + e0);
      acc[et][0] *= invd * sigmoidf_(bflo(og[0]));
      acc[et][1] *= invd * sigmoidf_(bfhi(og[0]));
      acc[et][2] *= invd * sigmoidf_(bflo(og[1]));
      acc[et][3] *= invd * sigmoidf_(bfhi(og[1]));
#pragma unroll
      for (int j = 0; j < 4; ++j) ss += acc[et][j] * acc[et][j];
    }
    ss = red16_sum(ss);
    const float rstd = rsqrtf(ss * (1.f / 128.f) + 1e-6f);
    const float* mw = p.in[21] + ei * 1024 + h * 128;
#pragma unroll
    for (int et = 0; et < 8; ++et) {
      const int e0 = et * 16 + q4 * 4;
      const u32x2 zz = *(const u32x2*)(Zg + (size_t)tok * 1024 + h * 128 + e0);
      const float4 w4 = *(const float4*)(mw + e0);
      const float r0 = acc[et][0] * rstd * w4.x * siluf_(bflo(zz[0]));
      const float r1 = acc[et][1] * rstd * w4.y * siluf_(bfhi(zz[0]));
      const float r2 = acc[et][2] * rstd * w4.z * siluf_(bflo(zz[1]));
      const float r3 = acc[et][3] * rstd * w4.w * siluf_(bfhi(zz[1]));
      *(u32x2*)(p.HC + (size_t)tok * PCC + 1024 + h * 128 + e0) = u32x2{pack2(r0, r1), pack2(r2, r3)};
    }
  }
  __syncthreads();
}

template <int L, bool FINAL, bool SAMPLE>
__device__ void rg_item(int wv, PRM p, char* smem, int o, int hc, int tokc0, int nsub, int seqstart, int chunk, int b) {
  const int tid = tid_opaque(wv), lane = tid & 63, w = tid >> 6, l15 = lane & 15, q4 = lane >> 4;
  u16* sX = (u16*)smem;
  u16* sA = sX + 67 * 136;
  u16* sZ = sA + 64 * 136;
  u16* sO = sZ + 64 * 136;
  const u16* XZ = p.PROJ;
  float ba[2], bx[2], cl[2], carryH[2], carryP[2];
  bf16x8 waf[2][4], wxf[2][4];
#pragma unroll
  for (int nt = 0; nt < 2; ++nt) {
    const int chl = w * 32 + nt * 16 + l15;
    const int chg = hc * 128 + chl;
    ba[nt] = p.in[27][o * 2048 + chg];
    bx[nt] = p.in[29][o * 2048 + chg];
    const float lm = p.in[30][o * 2048 + chg];
    const float sp = fmaxf(-lm, 0.f) + log1pf(__expf(-fabsf(lm)));
    cl[nt] = -8.f * sp;
#pragma unroll
    for (int ks = 0; ks < 4; ++ks) {
      waf[nt][ks] = *(const bf16x8*)(p.Wra[o] + (size_t)(hc * 128 + chl) * 128 + ks * 32 + q4 * 8);
      wxf[nt][ks] = *(const bf16x8*)(p.Wrx[o] + (size_t)(hc * 128 + chl) * 128 + ks * 32 + q4 * 8);
    }
    carryP[nt] = 1.f;
    if (SAMPLE) {
      carryH[nt] = p.in[10][(o * 16 + b) * 2048 + chg];
    } else {
      float hh = 0.f;
      if (FINAL) {
        for (int c2 = 0; c2 < chunk; c2 += 16) {
          float2 ag[16];
#pragma unroll
          for (int k = 0; k < 16; ++k) {
            ag[k] = make_float2(1.f, 0.f);
            if (c2 + k < chunk) ag[k] = *(const float2*)(p.AGG + ((size_t)(c2 + k) * 2048 + chg) * 2);
          }
#pragma unroll
          for (int k = 0; k < 16; ++k) hh = ag[k].x * hh + ag[k].y;
        }
      }
      carryH[nt] = hh;
    }
  }
  const int cg_ = tid & 15;
  float* sCW = (float*)(sO + 64 * 136);
  __syncthreads();
  for (int i = tid; i < 5 * 128; i += NTHR) {
    const int j = i >> 7, ch = i & 127;
    sCW[i] = (j < 4) ? p.in[24][(size_t)o * 4 * 2048 + j * 2048 + hc * 128 + ch] : p.in[25][(size_t)o * 2048 + hc * 128 + ch];
  }
  constexpr int NXI = ((L + 3) * 16 + 255) / 256;
  constexpr int NZI = L * 16 / 256;
  u32x4 rx[NXI], rz[NZI];
#define RG_LOAD(T0)                                                                                \
  {                                                                                                \
    _Pragma("unroll") for (int i = 0; i < NXI; ++i) {                                              \
      const int id = tid + i * 256;                                                                \
      const int r = id >> 4, cc = id & 15;                                                         \
      const int tk = (T0) - 3 + r;                                                                 \
      u32x4 v = u32x4{0u, 0u, 0u, 0u};                                                             \
      if (id < (L + 3) * 16) {                                                                     \
        if (tk >= seqstart) {                                                                      \
          v = *(const u32x4*)(XZ + (size_t)tk * 4096 + hc * 128 + cc * 8);                         \
        } else if (SAMPLE) {                                                                       \
          const float* bf = p.in[9] + ((size_t)(o * 16 + b) * 3 + r) * 2048 + hc * 128 + cc * 8;   \
          const float4 f0 = *(const float4*)bf, f1 = *(const float4*)(bf + 4);                     \
          v = u32x4{pack2(f0.x, f0.y), pack2(f0.z, f0.w), pack2(f1.x, f1.y), pack2(f1.z, f1.w)};   \
        }                                                                                          \
      }                                                                                            \
      rx[i] = v;                                                                                   \
    }                                                                                              \
    if (FINAL) {                                                                                   \
      _Pragma("unroll") for (int i = 0; i < NZI; ++i) {                                            \
        const int id = tid + i * 256;                                                              \
        rz[i] = *(const u32x4*)(XZ + (size_t)((T0) + (id >> 4)) * 4096 + 2048 + hc * 128 + (id & 15) * 8); \
      }                                                                                            \
    }                                                                                              \
  }
  RG_LOAD(tokc0)
  for (int st = 0; st < nsub; ++st) {
    const int t0 = tokc0 + st * L;
    __syncthreads();
#pragma unroll
    for (int i = 0; i < NXI; ++i) {
      const int id = tid + i * 256;
      if (id < (L + 3) * 16) *(u32x4*)(sX + (id >> 4) * 136 + (id & 15) * 8) = rx[i];
    }
    if (FINAL) {
#pragma unroll
      for (int i = 0; i < NZI; ++i) {
        const int id = tid + i * 256;
        *(u32x4*)(sZ + (id >> 4) * 136 + (id & 15) * 8) = rz[i];
      }
    }
    __syncthreads();
    {
      float cw[4][8], cb[8];
#pragma unroll
      for (int k = 0; k < 8; ++k) {
        cb[k] = sCW[4 * 128 + cg_ * 8 + k];
#pragma unroll
        for (int j = 0; j < 4; ++j) cw[j][k] = sCW[j * 128 + cg_ * 8 + k];
      }
#pragma unroll
      for (int i = 0; i < L * 16 / 256; ++i) {
        const int id = tid + i * 256;
        const int t = id >> 4;
        float xc[8];
#pragma unroll
        for (int k = 0; k < 8; ++k) xc[k] = cb[k];
#pragma unroll
        for (int j = 0; j < 4; ++j) {
          const u32x4 xv = *(const u32x4*)(sX + (t + j) * 136 + cg_ * 8);
#pragma unroll
          for (int q = 0; q < 4; ++q) {
            xc[2 * q] += cw[j][2 * q] * bflo(xv[q]);
            xc[2 * q + 1] += cw[j][2 * q + 1] * bfhi(xv[q]);
          }
        }
        *(u32x4*)(sA + t * 136 + cg_ * 8) =
            u32x4{pack2(xc[0], xc[1]), pack2(xc[2], xc[3]), pack2(xc[4], xc[5]), pack2(xc[6], xc[7])};
      }
    }
    __syncthreads();
    if (st + 1 < nsub) { RG_LOAD(t0 + L) }
    __builtin_amdgcn_sched_barrier(0);
#pragma unroll
    for (int nt = 0; nt < 2; ++nt) {
      constexpr int MTN = L / 16;
      const int chl = w * 32 + nt * 16 + l15;
      float hl[MTN][4], pl[MTN][4], Pt[MTN], Ht[MTN];
#pragma unroll
      for (int mt = 0; mt < MTN; ++mt) {
        f32x4 ar = f32x4{0.f, 0.f, 0.f, 0.f}, ai = f32x4{0.f, 0.f, 0.f, 0.f};
#pragma unroll
        for (int ks = 0; ks < 4; ++ks) {
          const bf16x8 a = *(const bf16x8*)(sA + (mt * 16 + l15) * 136 + ks * 32 + q4 * 8);
          ar = mfma16(a, waf[nt][ks], ar);
          ai = mfma16(a, wxf[nt][ks], ai);
        }
        float P = 1.f, H = 0.f;
#pragma unroll
        for (int j = 0; j < 4; ++j) {
          const int t = mt * 16 + q4 * 4 + j;
          const float xc = bf2f(sA[t * 136 + chl]);
          const float rr = sigmoidf_(ar[j] + ba[nt]);
          const float ii = sigmoidf_(ai[j] + bx[nt]);
          const float la = cl[nt] * rr;
          const float a = __expf(la);
          const float x2 = 2.f * la;
          const float om = (x2 > -0.02f) ? (-x2 * (1.f + x2 * (0.5f + x2 * (1.f / 6.f)))) : (1.f - a * a);
          const float u = __builtin_amdgcn_sqrtf(om) * ii * xc;
          H = a * H + u;
          P = a * P;
          hl[mt][j] = H; pl[mt][j] = P;
        }
        Pt[mt] = P; Ht[mt] = H;
      }
      float Pe[MTN], He[MTN], Pq[MTN], Hq[MTN];
#pragma unroll
      for (int mt = 0; mt < MTN; ++mt) {
        const float Pp = __shfl_up(Pt[mt], 16), Hp = __shfl_up(Ht[mt], 16);
        if (q4 >= 1) { Ht[mt] = Pt[mt] * Hp + Ht[mt]; Pt[mt] = Pt[mt] * Pp; }
      }
#pragma unroll
      for (int mt = 0; mt < MTN; ++mt) {
        const float Pp = __shfl_up(Pt[mt], 32), Hp = __shfl_up(Ht[mt], 32);
        if (q4 >= 2) { Ht[mt] = Pt[mt] * Hp + Ht[mt]; Pt[mt] = Pt[mt] * Pp; }
      }
#pragma unroll
      for (int mt = 0; mt < MTN; ++mt) {
        Pe[mt] = __shfl_up(Pt[mt], 16); He[mt] = __shfl_up(Ht[mt], 16);
        if (q4 == 0) { Pe[mt] = 1.f; He[mt] = 0.f; }
        Pq[mt] = __shfl(Pt[mt], 48 + l15); Hq[mt] = __shfl(Ht[mt], 48 + l15);
      }
#pragma unroll
      for (int mt = 0; mt < MTN; ++mt) {
        const float hb = Pe[mt] * carryH[nt] + He[mt];
        if (FINAL) {
#pragma unroll
          for (int j = 0; j < 4; ++j) {
            const int t = mt * 16 + q4 * 4 + j;
            const float hv = pl[mt][j] * hb + hl[mt][j];
            const float z = bf2f(sZ[t * 136 + chl]);
            sO[t * 136 + chl] = f2bf(hv * siluf_(z));
            if (st == nsub - 1 && mt == MTN - 1 && j == 3 && q4 == 3) {
              if (SAMPLE) p.rgs[(o * 16 + b) * 2048 + hc * 128 + chl] = hv;
              else if (chunk == 63) p.rgp[o * 2048 + hc * 128 + chl] = hv;
            }
          }
        }
        carryH[nt] = Pq[mt] * carryH[nt] + Hq[mt];
        carryP[nt] = carryP[nt] * Pq[mt];
      }
    }
    if (FINAL) {
      __syncthreads();
#pragma unroll
      for (int i = 0; i < L * 16 / 256; ++i) {
        const int id = tid + i * 256;
        *(u32x4*)(p.HC + (size_t)(t0 + (id >> 4)) * PCC + hc * 128 + (id & 15) * 8) =
            *(const u32x4*)(sO + (id >> 4) * 136 + (id & 15) * 8);
      }
      if (st == nsub - 1 && (SAMPLE || chunk == 63)) {
        for (int id = tid; id < 3 * 128; id += NTHR) {
          const int j = id >> 7, ch = id & 127;
          const float v = bf2f(sX[(L + j) * 136 + ch]);
          if (SAMPLE) p.convs[((size_t)(o * 16 + b) * 3 + j) * 2048 + hc * 128 + ch] = v;
          else p.convp[((size_t)o * 3 + j) * 2048 + hc * 128 + ch] = v;
        }
      }
    }
  }
  if (!FINAL) {
    if (q4 == 0) {
#pragma unroll
      for (int nt = 0; nt < 2; ++nt) {
        const int chg = hc * 128 + w * 32 + nt * 16 + l15;
        *(float2*)(p.AGG + ((size_t)chunk * 2048 + chg) * 2) = make_float2(carryP[nt], carryH[nt]);
      }
    }
  }
#undef RG_LOAD
}

#define XB_TMO      128
#define XB_XCNT(j)  (256  + 64 * (j))
#define XB_XSUB(j)  (1280 + 64 * (j))
#define XB_XGEN(j)  (2304 + 64 * (j))
#define XB_TOP      3328
#define XB_TOPGEN   3392
#define XCD_BAR_WORDS 3456
#define XB_SPIN_CAP (1u << 18)
__device__ __forceinline__ unsigned xb_ld(unsigned* p)              { return __hip_atomic_load(p, __ATOMIC_RELAXED, __HIP_MEMORY_SCOPE_AGENT); }
__device__ __forceinline__ unsigned xb_add(unsigned* p, unsigned v) { return __hip_atomic_fetch_add(p, v, __ATOMIC_RELAXED, __HIP_MEMORY_SCOPE_AGENT); }
__device__ __forceinline__ unsigned xb_xcc_id() { return (unsigned)__builtin_amdgcn_s_getreg((3 << 11) | 20) & 0xFu; }
#define XB_SPIN(cond, bar) do { unsigned _sp = 0; while (cond) { __builtin_amdgcn_s_sleep(1); \
    if ((++_sp & 255u) == 0u) { if (xb_ld(&(bar)[XB_TMO])) break; if (_sp > XB_SPIN_CAP) { atomicAdd(&(bar)[XB_TMO], 1u); break; } } } } while (0)
struct XcdBarrier { unsigned* bar; unsigned x; volatile LAS unsigned* st; };
__device__ __forceinline__ XcdBarrier xcd_barrier_post(unsigned* bar, volatile LAS unsigned* st) {
    XcdBarrier b; b.bar = bar; b.x = xb_xcc_id(); b.st = st;
    if (threadIdx.x == 0) (void)xb_add(&bar[XB_XCNT(b.x)], 1u);
    return b;
}
__device__ __forceinline__ void xcd_barrier_complete(unsigned* bar, unsigned x, unsigned& nloc, unsigned& nx) {
    const unsigned G = gridDim.x * gridDim.y * gridDim.z;
    unsigned sum, cnt, mine, sp = 0u;
    for (;;) {
        sum = 0u; cnt = 0u; mine = 0u;
#pragma unroll
        for (unsigned j = 0; j < 16; ++j) { const unsigned c = xb_ld(&bar[XB_XCNT(j)]); sum += c; cnt += (c > 0u) ? 1u : 0u; mine = (j == x) ? c : mine; }
        if (sum == G) break;
        __builtin_amdgcn_s_sleep(1);
        if ((++sp & 255u) == 0u) { if (xb_ld(&bar[XB_TMO])) break; if (sp > XB_SPIN_CAP) { atomicAdd(&bar[XB_TMO], 1u); break; } }
    }
    nloc = mine > 0u ? mine : 1u; nx = cnt > 0u ? cnt : 1u;
}
__device__ __forceinline__ void xcd_barrier(const XcdBarrier& b, bool leader) {
    asm volatile("s_waitcnt vmcnt(0)" ::: "memory");
    __syncthreads();
    if (leader) {
        unsigned* bar = b.bar;
        __builtin_amdgcn_s_waitcnt(0);
        unsigned nloc = b.st[0], nx = b.st[1];
        if (nloc == 0u) { xcd_barrier_complete(bar, b.x, nloc, nx); b.st[0] = nloc; b.st[1] = nx; }
        const unsigned old = xb_add(&bar[XB_XSUB(b.x)], 1u);
        const unsigned gen = old / nloc;
        if (old + 1u == (gen + 1u) * nloc) {
            __builtin_amdgcn_fence(__ATOMIC_RELEASE, "agent");
            asm volatile("s_waitcnt vmcnt(0)" ::: "memory");
            const unsigned og = xb_add(&bar[XB_TOP], 1u);
            const unsigned tg = og / nx;
            if (og + 1u == (tg + 1u) * nx) xb_add(&bar[XB_TOPGEN], 1u);
            else XB_SPIN(xb_ld(&bar[XB_TOPGEN]) == tg, bar);
            __builtin_amdgcn_fence(__ATOMIC_ACQUIRE, "agent");
            xb_add(&bar[XB_XGEN(b.x)], 1u);
            asm volatile("s_waitcnt vmcnt(0)" ::: "memory");
        } else {
            XB_SPIN(xb_ld(&bar[XB_XGEN(b.x)]) == gen, bar);
            __builtin_amdgcn_fence(__ATOMIC_ACQUIRE, "agent");
            asm volatile("s_waitcnt vmcnt(0)" ::: "memory");
        }
    }
    __syncthreads();
}

__device__ __forceinline__ int snake(int r, int G, int b) { return (r & 1) ? (r * G + (G - 1 - b)) : (r * G + b); }
__device__ __forceinline__ PRMP launder(PRMP q) { asm volatile("" : "+s"(q)); return q; }

__device__ void attn_phase(int wv, PRMP pp, char* smem, int li) {
  const int G = gridDim.x, bid = blockIdx.x, ei = li >> 1;
  const float lam_init = 0.8f - 0.6f * expf(-0.3f * (float)li);
  float lam;
  {
    PRM p = *launder(pp);
    const int lane = tid_opaque(wv) & 63;
    const float s1 = wave_sum(p.in[16][ei * 64 + lane] * p.in[17][ei * 64 + lane]);
    const float s2 = wave_sum(p.in[18][ei * 64 + lane] * p.in[19][ei * 64 + lane]);
    lam = expf(s1) - expf(s2) + lam_init;
  }
  const int hx = bid & 7;
  __shared__ int s_q;
  unsigned* qw = launder(pp)->BAR + XCD_BAR_WORDS + (ei * 4) * 8 * 64 + hx * 64;
  const bool leader = tid_opaque(wv) == 0;
#define Q_PULL(QI, DST)                                                     \
  {                                                                         \
    if (leader) s_q = (int)xb_add(qw + (QI) * 8 * 64, 1u);                  \
    __syncthreads();                                                        \
    DST = s_q;                                                              \
    __syncthreads();                                                        \
  }
  {
    PRM p = *launder(pp);
    for (;;) {
      int it; Q_PULL(0, it)
      if (it >= 16) break;
      attn_item<1, true>(wv, p, smem, ei, hx, it, lam, lam_init);
    }
  }
  {
    PRM p = *launder(pp);
    for (;;) {
      int k; Q_PULL(1, k)
      if (k >= 256) break;
      attn_prompt_item(wv, p, smem, ei, hx, 255 - k, lam, lam_init);
    }
  }
  {
    PRM p = *launder(pp);
    for (;;) {
      int k; Q_PULL(2, k)
      if (k >= 256) break;
      m1_item<64>(wv, p, smem, ei, k, hx, k * 64);
    }
  }
  {
    PRM p = *launder(pp);
    for (;;) {
      int k; Q_PULL(3, k)
      if (k >= 16) break;
      m1_item<32>(wv, p, smem, ei, 256 + k, hx, SP + k * 32);
    }
  }
#undef Q_PULL
}

__device__ void run_phase(int wv, PRMP pp, char* smem, int ph) {
  const int G = gridDim.x, bid = blockIdx.x;
  if (ph == 0) { if (PM & 1) prologue_phase(wv, *launder(pp), smem); return; }
  if (ph == 25) { if (PM & 2) norm_phase(wv, *launder(pp), 4); return; }
  const int li = (ph - 1) / 6, sub = (ph - 1) % 6;
  const bool even = (li & 1) == 0;
  const int ei = li >> 1, o = li >> 1;
  if (sub == 0) { if (PM & 2) norm_phase(wv, *launder(pp), li); return; }
  if (sub == 1) {
    if (!(PM & 4)) return;
    PRM p = *launder(pp);
    if (even) gemm_phase<EPI_INEVEN, 256>(wv, p, smem, p.HC, 1024, p.Wie[ei], 1024, 1024, 73, li);
    else gemm_phase<EPI_INODD, 256>(wv, p, smem, p.HC, 1024, p.Wio[o], 1024, 1024, 32, li);
    return;
  }
  if (sub == 5) {
    PRM p = *launder(pp);
    if (PM & 8) gemm_phase<EPI_OUT, 128>(wv, p, smem, p.HC, PCC, even ? p.Woe[ei] : p.Woo[o], PWO, 2048, 8, li);
    return;
  }
  if (even) {
    if (sub == 2) {
      attn_phase(wv, pp, smem, li);
    } else if (sub == 3) {
      if (PM & 128) m2_phase(wv, *launder(pp), ei);
    } else {
      if (PM & 256) {
        { PRM p = *launder(pp);
          for (int it = bid; it < 2048; it += G) m3_item<64>(wv, p, smem, ei, it >> 3, it & 7, (it >> 3) * 64); }
        { PRM p = *launder(pp);
          for (int k2 = G - 1 - bid; k2 < 128; k2 += G) m3_item<32>(wv, p, smem, ei, 256 + (k2 >> 3), k2 & 7, SP + (k2 >> 3) * 32); }
      }
    }
  } else {
    if (sub == 2) {
      PRM p = *launder(pp);
      if (PM & 512) for (int it = bid; it < 63 * 16; it += G)
        rg_item<64, false, false>(wv, p, smem, o, it & 15, (it >> 4) * 256, 4, 0, it >> 4, 0);
    } else if (sub == 3) {
      if (PM & 1024) {
        { PRM p = *launder(pp);
          for (int it = bid; it < 1024; it += G) rg_item<64, true, false>(wv, p, smem, o, it & 15, (it >> 4) * 256, 4, 0, it >> 4, 0); }
        { PRM p = *launder(pp);
          for (int k = G - 1 - bid; k < 256; k += G) rg_item<32, true, true>(wv, p, smem, o, k & 15, SP + (k >> 4) * 32, 1, SP + (k >> 4) * 32, 0, k >> 4); }
      }
    }
  }
}

__device__ __forceinline__ bool phase_is_nop(int ph) {
  if (ph == 0 || ph == 25) return false;
  const int li = (ph - 1) / 6, sub = (ph - 1) % 6;
  return (li & 1) && sub == 4;
}

__global__ void __launch_bounds__(NTHR, 2) fwd_kernel(Params p_unused, int ph_begin, int ph_end) {
  __shared__ __attribute__((aligned(16))) char smem[SMEM_BYTES];
  __shared__ uint4 xb_words;
  PRMP pp = (PRMP)__builtin_amdgcn_kernarg_segment_ptr();
  const int wv = __builtin_amdgcn_readfirstlane((int)(threadIdx.x >> 6));
  if (threadIdx.x == 0) xb_words = make_uint4(0u, 0u, 0u, 0u);
  __syncthreads();
  if (ph_end - ph_begin > 1) (void)xcd_barrier_post(launder(pp)->BAR, (volatile LAS unsigned*)&xb_words);
  int nsync = 0;
  for (int ph2 = ph_begin * 2; ph2 < ph_end * 2; ++ph2) {
    const int ph = ph2 >> 1;
    if (phase_is_nop(ph)) continue;
    if (ph2 & 1) {
      if (!REP) continue;
      const int li = (ph - 1) / 6, sub = (ph - 1) % 6;
      int bit = 0;
      if (ph == 0) bit = 1;
      else if (ph == 25) bit = 0;
      else if (sub == 0) bit = 2;
      else if (sub == 1) bit = 4;
      else if (sub == 2) bit = (li & 1) ? 512 : 0x70;
      else if (sub == 3) bit = (li & 1) ? 1024 : 0;
      else if (sub == 4) bit = 256;
      else if (sub == 5 && li == 0) bit = 0x800;
      if (!(REP & bit)) continue;
    }
    if (ph2 != ph_begin * 2) {
      if (ph_begin < 0) cg::this_grid().sync();
      {
        XcdBarrier xb;
        xb.bar = launder(pp)->BAR; xb.x = xb_xcc_id(); xb.st = (volatile LAS unsigned*)&xb_words;
        xcd_barrier(xb, wv == 0 && __lane_id() == 0);
      }
      ++nsync;
    }
    run_phase(wv, pp, smem, ph);
  }
}

extern "C" void kernel_launch(void* const* d_in, const int* in_sizes, int n_in, void* d_out, int out_size,
                              void* d_ws, size_t ws_size, hipStream_t stream) {
  Params p;
  memset(&p, 0, sizeof(p));
  for (int i = 0; i < 33; ++i) p.in[i] = (const float*)d_in[i];
  float* o = (float*)d_out;
  size_t off = 0;
  p.y = o; off += (size_t)NT * 1024;
  p.kp = o + off; off += (size_t)2 * SP * 1024;
  p.vp = o + off; off += (size_t)2 * SP * 1024;
  p.mcp = o + off; off += (size_t)2 * 8 * 16384;
  p.mnp = o + off; off += 2 * 8 * 128;
  p.mmp = o + off; off += 2 * 8;
  p.convp = o + off; off += 2 * 3 * 2048;
  p.rgp = o + off; off += 2 * 2048;
  p.ks = o + off; off += (size_t)2 * 512 * 1024;
  p.vs = o + off; off += (size_t)2 * 512 * 1024;
  p.mcs = o + off; off += (size_t)2 * 16 * 8 * 16384;
  p.mns = o + off; off += 2 * 16 * 8 * 128;
  p.mms = o + off; off += 2 * 16 * 8;
  p.convs = o + off; off += 2 * 16 * 3 * 2048;
  p.rgs = o + off; off += 2 * 16 * 2048;

  char* ws = (char*)d_ws;
  size_t wo = 0;
  auto take = [&](size_t bytes) { char* r = ws + wo; wo += (bytes + 255) & ~(size_t)255; return r; };
  p.HC = (u16*)take((size_t)NT * PCC * 2);
  p.PROJ = (u16*)take((size_t)NT * 9216 * 2);
  p.UST = (u16*)take((size_t)NSLOT * 8 * 16384 * 2);
  for (int e = 0; e < 2; ++e) p.Wie[e] = (u16*)take((size_t)9344 * 1024 * 2);
  for (int e = 0; e < 2; ++e) p.Woe[e] = (u16*)take((size_t)1024 * PWO * 2);
  for (int e = 0; e < 2; ++e) p.Wio[e] = (u16*)take((size_t)4096 * 1024 * 2);
  for (int e = 0; e < 2; ++e) p.Woo[e] = (u16*)take((size_t)1024 * PWO * 2);
  for (int e = 0; e < 2; ++e) p.Wra[e] = (u16*)take((size_t)16 * 128 * 128 * 2);
  for (int e = 0; e < 2; ++e) p.Wrx[e] = (u16*)take((size_t)16 * 128 * 128 * 2);
  p.MODS = (float*)take((size_t)4 * 17 * 3072 * 4);
  p.GATES = (float*)take((size_t)NT * 16 * 4);
  p.AB = (float*)take((size_t)NSLOT * 8 * 2 * 4);
  p.NST = (float*)take((size_t)NSLOT * 8 * 128 * 4);
  p.MST = (float*)take((size_t)NSLOT * 8 * 4);
  p.AGG = (float*)take((size_t)64 * 2048 * 2 * 4);
  p.BAR = (unsigned*)take((size_t)(XCD_BAR_WORDS + 2 * 4 * 8 * 64) * 4);
  if (wo > ws_size) { fprintf(stderr, "workspace too small: need %zu have %zu\n", wo, ws_size); return; }

  int ti = 0, tstart = 0;
  auto addt = [&](const float* src, u16* dst, int K, int N, int Npad, int nb, int ldd) {
    TDesc& d = p.td[ti++];
    d.src = src; d.dst = dst; d.K = K; d.N = N; d.Npad = Npad; d.nb = nb; d.tstart = tstart; d.ldd = ldd;
    d.per = (K / 64) * (Npad / 64);
    tstart += d.per * nb;
  };
  for (int e = 0; e < 2; ++e) addt(p.in[14] + (size_t)e * 1024 * 9232, p.Wie[e], 1024, 9232, 9344, 1, 1024);
  for (int e = 0; e < 2; ++e) addt(p.in[22] + (size_t)e * 2048 * 1024, p.Woe[e], 2048, 1024, 1024, 1, PWO);
  for (int e = 0; e < 2; ++e) addt(p.in[23] + (size_t)e * 1024 * 4096, p.Wio[e], 1024, 4096, 4096, 1, 1024);
  for (int e = 0; e < 2; ++e) addt(p.in[31] + (size_t)e * 2048 * 1024, p.Woo[e], 2048, 1024, 1024, 1, PWO);
  for (int e = 0; e < 2; ++e) addt(p.in[26] + (size_t)e * 16 * 16384, p.Wra[e], 128, 128, 128, 16, 128);
  for (int e = 0; e < 2; ++e) addt(p.in[28] + (size_t)e * 16 * 16384, p.Wrx[e], 128, 128, 128, 16, 128);
  p.ntr = tstart;

  static int grid_blocks = 0;
  if (!grid_blocks) {
    int dev = 0, cus = 0, per_cu = 0;
    hipGetDevice(&dev);
    hipDeviceGetAttribute(&cus, hipDeviceAttributeMultiprocessorCount, dev);
    hipOccupancyMaxActiveBlocksPerMultiprocessor(&per_cu, fwd_kernel, NTHR, 0);
    if (per_cu > 2) per_cu = 2;
    if (per_cu < 1) per_cu = 1;
    grid_blocks = cus * per_cu;
  }
#if MEGA
  hipMemsetAsync(p.BAR, 0, (size_t)(XCD_BAR_WORDS + 2 * 4 * 8 * 64) * 4, stream);
  int b = 0, e = 26;
  void* args[] = {&p, &b, &e};
  hipError_t err = hipLaunchCooperativeKernel((void*)fwd_kernel, dim3(grid_blocks), dim3(NTHR), args, 0, stream);
  if (err != hipSuccess) fprintf(stderr, "cooperative launch failed: %s (grid %d)\n", hipGetErrorString(err), grid_blocks);
#else
  for (int ph = 0; ph < 26; ++ph) {
    bool nop = false;
    if (ph != 0 && ph != 25) { int li = (ph - 1) / 6, sub = (ph - 1) % 6; nop = (li & 1) && sub == 4; }
    if (nop) continue;
    fwd_kernel<<<grid_blocks, NTHR, 0, stream>>>(p, ph, ph + 1);
  }
#endif
}
```
